# Optimizing an MI355X kernel written in HIP

```python
import math
import jax, jax.numpy as jnp
from jax import lax
import numpy as np

D_MODEL = 1024
BATCH = 8
SEQ = 4096
DEPTH = 2
DEC_BATCH = 16
DEC_SEQ = 32
PAST_LEN = 1024

CHUNK = 64
POOL_WINDOWS = (2, 4, 8, 16)
N_POOL_GROUPS = 4
POOL_WIDTH = D_MODEL
POOL_GROUP = POOL_WIDTH // N_POOL_GROUPS
POOL_STATE = 15
HEAD_DK = 128
HEAD_DV = 128
N_HEADS = D_MODEL // HEAD_DV
QK_WIDTH = N_HEADS * HEAD_DK
V_WIDTH = N_HEADS * HEAD_DV
CONV_WIDTH = 4
CONV_CH = 2 * QK_WIDTH + V_WIDTH
D_FF = 4 * D_MODEL
ALPHA = (2 * DEPTH) ** 0.25
BETA_INIT = (8 * DEPTH) ** -0.25
LN_EPS = 1e-5
RMS_EPS = 1e-6
L2_EPS = 1e-6
OFF_POOL = POOL_WIDTH
OFF_QKV = OFF_POOL + CONV_CH
OFF_Z = OFF_QKV + V_WIDTH
OFF_GA = OFF_Z + D_MODEL
OFF_GB = OFF_GA + D_MODEL
OFF_BETA = OFF_GB + N_HEADS
IN_WIDTH = OFF_BETA + N_HEADS

kernel_name = "hybrid_pool_gdn_streaming_step"


def layer_norm(x, g, b):
    xf = x.astype(jnp.float32)
    mu = jnp.mean(xf, -1, keepdims=True)
    var = jnp.mean(jnp.square(xf - mu), -1, keepdims=True)
    return ((xf - mu) * lax.rsqrt(var + LN_EPS) * g.astype(jnp.float32) + b.astype(jnp.float32)).astype(x.dtype)


def l2_normalize(x):
    xf = x.astype(jnp.float32)
    return xf * lax.rsqrt(jnp.sum(xf * xf, -1, keepdims=True) + L2_EPS)


def pool_mixer(u_ext, pos0, w_pool, pool_scale):
    B, Lx, _ = u_ext.shape
    L = Lx - POOL_STATE
    uf = u_ext.astype(jnp.float32)
    cs = jnp.concatenate([jnp.zeros((B, 1, POOL_WIDTH), jnp.float32), jnp.cumsum(uf, axis=1)], axis=1)
    end = cs[:, POOL_STATE + 1:]
    pos = pos0 + jnp.arange(L)
    means = []
    for gi, w in enumerate(POOL_WINDOWS):
        lo, hi = gi * POOL_GROUP, (gi + 1) * POOL_GROUP
        start = cs[:, POOL_STATE + 1 - w: POOL_STATE + 1 - w + L, lo:hi]
        cnt = jnp.minimum(w, pos + 1).astype(jnp.float32)[None, :, None]
        means.append((end[..., lo:hi] - start) / cnt)
    mixed = (jnp.concatenate(means, -1) - uf[:, POOL_STATE:]).astype(u_ext.dtype)
    mixed = mixed.reshape(B, L, N_POOL_GROUPS, POOL_GROUP)
    y = jnp.einsum('blgc,gcd->blgd', mixed, w_pool).reshape(B, L, POOL_WIDTH)
    return y * pool_scale


def causal_short_conv(x_ext, conv_w):
    L = x_ext.shape[1] - (CONV_WIDTH - 1)
    y = x_ext[:, 0:L] * conv_w[0]
    for t in range(1, CONV_WIDTH):
        y = y + x_ext[:, t:t + L] * conv_w[t]
    return jax.nn.silu(y)


def gated_delta_rule(q, k, v, g, beta, S0):
    B, L, H, DK = q.shape
    DV = v.shape[-1]
    C = min(CHUNK, L)
    n = L // C
    f32 = jnp.float32

    def chunks4(t):
        return jnp.moveaxis(t.astype(f32).reshape(B, n, C, H, t.shape[-1]), 3, 2)

    def chunks3(t):
        return jnp.moveaxis(t.astype(f32).reshape(B, n, C, H), 3, 2)

    qc, kc, vc = chunks4(q), chunks4(k), chunks4(v)
    gc = jnp.cumsum(chunks3(g), axis=-1)
    bc = chunks3(beta)
    idx = jnp.arange(C)
    incl = idx[:, None] >= idx[None, :]
    strict = idx[:, None] > idx[None, :]
    decay = jnp.exp(jnp.where(incl, gc[..., :, None] - gc[..., None, :], -jnp.inf))
    kb = kc * bc[..., None]
    lower = jnp.where(strict, jnp.einsum('bnhid,bnhjd->bnhij', kb, kc) * decay, 0.0)
    a_mat = jnp.eye(C, dtype=f32) + lower
    rhs = jnp.concatenate([vc * bc[..., None], kb * jnp.exp(gc)[..., None]], axis=-1)
    sol = lax.linalg.triangular_solve(a_mat, rhs, left_side=True, lower=True, unit_diagonal=True)
    u_val, w_dec = sol[..., :DV], sol[..., DV:]
    attn_in = jnp.einsum('bnhid,bnhjd->bnhij', qc, kc) * decay
    q_dec = qc * jnp.exp(gc)[..., None]
    k_tail = kc * jnp.exp(gc[..., -1:] - gc)[..., None]
    g_tot = jnp.exp(gc[..., -1])

    def step(S, inp):
        u_i, w_i, a_i, qd_i, kt_i, gt_i = inp
        v_new = u_i - jnp.einsum('bhcd,bhde->bhce', w_i, S)
        o_i = jnp.einsum('bhcd,bhde->bhce', qd_i, S) + jnp.einsum('bhij,bhje->bhie', a_i, v_new)
        S = S * gt_i[..., None, None] + jnp.einsum('bhcd,bhce->bhde', kt_i, v_new)
        return S, o_i

    xs = tuple(jnp.moveaxis(t, 1, 0) for t in (u_val, w_dec, attn_in, q_dec, k_tail, g_tot))
    S_fin, o = lax.scan(step, S0.astype(f32), xs)
    o = jnp.transpose(o, (1, 0, 3, 2, 4)).reshape(B, L, H, DV)
    return o.astype(v.dtype), S_fin.astype(S0.dtype)


def delta_branch(qkv_ext, z, b_raw, a_raw, S0, conv_w, a_log, dt_bias, o_gain):
    B = qkv_ext.shape[0]
    qkv = causal_short_conv(qkv_ext, conv_w)
    L = qkv.shape[1]
    q, k, v = jnp.split(qkv, [QK_WIDTH, 2 * QK_WIDTH], axis=-1)
    q = l2_normalize(q.reshape(B, L, N_HEADS, HEAD_DK)) * (HEAD_DK ** -0.5)
    k = l2_normalize(k.reshape(B, L, N_HEADS, HEAD_DK))
    v = v.reshape(B, L, N_HEADS, HEAD_DV)
    beta = jax.nn.sigmoid(b_raw.astype(jnp.float32))
    g = -jnp.exp(a_log.astype(jnp.float32)) * jax.nn.softplus(a_raw.astype(jnp.float32) + dt_bias.astype(jnp.float32))
    o, S = gated_delta_rule(q, k, v, g, beta, S0)
    of = o.astype(jnp.float32)
    of = of * lax.rsqrt(jnp.mean(of * of, -1, keepdims=True) + RMS_EPS) * o_gain.astype(jnp.float32)
    of = of * jax.nn.silu(z.astype(jnp.float32).reshape(B, L, N_HEADS, HEAD_DV))
    return of.reshape(B, L, V_WIDTH).astype(qkv_ext.dtype), S


def trunk_layer(x, pool_hist, conv_hist, S0, pos0, w_in, conv_w, a_log, dt_bias, o_gain, w_pool, pool_scale,
                w_out, ln1_g, ln1_b, w_ff1, b_ff1, w_ff2, b_ff2, ln2_g, ln2_b):
    proj = jnp.einsum('bld,de->ble', x, w_in)
    u_pool, qkv, z, ga, gb, b_raw, a_raw = jnp.split(proj, [OFF_POOL, OFF_QKV, OFF_Z, OFF_GA, OFF_GB, OFF_BETA], axis=-1)
    pool_ext = jnp.concatenate([pool_hist, u_pool], axis=1)
    conv_ext = jnp.concatenate([conv_hist, qkv], axis=1)
    y_a = pool_mixer(pool_ext, pos0, w_pool, pool_scale)
    y_b, S_new = delta_branch(conv_ext, z, b_raw, a_raw, S0, conv_w, a_log, dt_bias, o_gain)
    merged = jax.nn.sigmoid(ga) * y_a + jax.nn.sigmoid(gb) * y_b
    x = layer_norm(ALPHA * x + jnp.einsum('bld,de->ble', merged, w_out), ln1_g, ln1_b)
    h = jnp.square(jax.nn.relu(jnp.einsum('bld,df->blf', x, w_ff1) + b_ff1))
    x = layer_norm(ALPHA * x + jnp.einsum('blf,fd->bld', h, w_ff2) + b_ff2, ln2_g, ln2_b)
    return x, pool_ext[:, -POOL_STATE:], conv_ext[:, -(CONV_WIDTH - 1):], S_new


def setup_inputs(seed: int = 0) -> dict:
    key = jax.random.key(seed)
    ks = jax.random.split(key, 24)
    f32 = jnp.float32
    nrm = lambda k, shape, s: jax.random.normal(k, shape, f32) * s
    dt = jnp.exp(jax.random.uniform(ks[7], (DEPTH, N_HEADS), f32) * (math.log(0.1) - math.log(0.001)) + math.log(0.001))
    return {
        "x_prompt": nrm(ks[0], (BATCH, SEQ, D_MODEL), 1.0),
        "x_sample": nrm(ks[1], (DEC_BATCH, DEC_SEQ, D_MODEL), 1.0),
        "state_pool": nrm(ks[2], (DEPTH, DEC_BATCH, POOL_STATE, POOL_WIDTH), 1.0),
        "state_conv": nrm(ks[3], (DEPTH, DEC_BATCH, CONV_WIDTH - 1, CONV_CH), 1.0),
        "state_delta": nrm(ks[4], (DEPTH, DEC_BATCH, N_HEADS, HEAD_DK, HEAD_DV), 0.1),
        "ln_in_g": 1.0 + nrm(ks[5], (D_MODEL,), 0.02),
        "ln_in_b": nrm(ks[6], (D_MODEL,), 0.02),
        "w_in": nrm(ks[8], (DEPTH, D_MODEL, IN_WIDTH), D_MODEL ** -0.5),
        "conv_w": nrm(ks[9], (DEPTH, CONV_WIDTH, CONV_CH), CONV_WIDTH ** -0.5),
        "a_log": jnp.log(jax.random.uniform(ks[10], (DEPTH, N_HEADS), f32, 1.0, 16.0)),
        "dt_bias": dt + jnp.log(-jnp.expm1(-dt)),
        "o_gain": 1.0 + nrm(ks[11], (DEPTH, HEAD_DV), 0.02),
        "w_pool": nrm(ks[12], (DEPTH, N_POOL_GROUPS, POOL_GROUP, POOL_GROUP), POOL_GROUP ** -0.5),
        "pool_scale": 1.0 + nrm(ks[13], (DEPTH, POOL_WIDTH), 0.02),
        "w_out": nrm(ks[14], (DEPTH, D_MODEL, D_MODEL), BETA_INIT * D_MODEL ** -0.5),
        "ln1_g": 1.0 + nrm(ks[15], (DEPTH, D_MODEL), 0.02),
        "ln1_b": nrm(ks[16], (DEPTH, D_MODEL), 0.02),
        "w_ff1": nrm(ks[17], (DEPTH, D_MODEL, D_FF), D_MODEL ** -0.5),
        "b_ff1": nrm(ks[18], (DEPTH, D_FF), 0.02),
        "w_ff2": nrm(ks[19], (DEPTH, D_FF, D_MODEL), BETA_INIT * D_FF ** -0.5),
        "b_ff2": nrm(ks[20], (DEPTH, D_MODEL), 0.02),
        "ln2_g": 1.0 + nrm(ks[21], (DEPTH, D_MODEL), 0.02),
        "ln2_b": nrm(ks[22], (DEPTH, D_MODEL), 0.02),
    }


def reference(x_prompt, x_sample, state_pool, state_conv, state_delta, ln_in_g, ln_in_b, w_in, conv_w, a_log,
              dt_bias, o_gain, w_pool, pool_scale, w_out, ln1_g, ln1_b, w_ff1, b_ff1, w_ff2, b_ff2, ln2_g, ln2_b):
    B = x_prompt.shape[0]
    dt = x_prompt.dtype
    xp = layer_norm(x_prompt, ln_in_g, ln_in_b)
    xs = layer_norm(x_sample, ln_in_g, ln_in_b)
    pool_p, conv_p, delta_p, pool_s, conv_s, delta_s = [], [], [], [], [], []
    for l in range(DEPTH):
        lw = (w_in[l], conv_w[l], a_log[l], dt_bias[l], o_gain[l], w_pool[l], pool_scale[l], w_out[l],
              ln1_g[l], ln1_b[l], w_ff1[l], b_ff1[l], w_ff2[l], b_ff2[l], ln2_g[l], ln2_b[l])
        xp, pp, cp, sp = trunk_layer(xp,
                                     jnp.zeros((B, POOL_STATE, POOL_WIDTH), dt),
                                     jnp.zeros((B, CONV_WIDTH - 1, CONV_CH), dt),
                                     jnp.zeros((B, N_HEADS, HEAD_DK, HEAD_DV), dt),
                                     0, *lw)
        xs, ps, cs, ss = trunk_layer(xs, state_pool[l], state_conv[l], state_delta[l], PAST_LEN, *lw)
        pool_p.append(pp); conv_p.append(cp); delta_p.append(sp)
        pool_s.append(ps); conv_s.append(cs); delta_s.append(ss)
    return (xp, xs, jnp.stack(pool_p), jnp.stack(conv_p), jnp.stack(delta_p),
            jnp.stack(pool_s), jnp.stack(conv_s), jnp.stack(delta_s))
```

```cpp
#include <hip/hip_runtime.h>
#include <hip/hip_cooperative_groups.h>
#include <cstdio>
namespace cg = cooperative_groups;

#ifndef MK_SINGLE
#define MK_SINGLE 1
#endif

#define LAS __attribute__((address_space(3)))
#define GAS __attribute__((address_space(1)))
typedef unsigned short bf16_t;
typedef short bf16x8 __attribute__((ext_vector_type(8)));
typedef float f32x4 __attribute__((ext_vector_type(4)));
typedef unsigned u32x4 __attribute__((ext_vector_type(4)));
typedef unsigned u32x2 __attribute__((ext_vector_type(2)));

constexpr int DM = 1024, SEQ = 4096, RP = 8 * SEQ, RS = 16 * 32, R = RP + RS;
constexpr int INW = 7184, DFF = 4096;
constexpr int NCHH = (512 + 16) * 8;
constexpr size_t SLOT = (size_t)NCHH * 8192;
constexpr float ALPHA = 1.41421356237f;
constexpr size_t WIN_E = 0, WPOOL_E = 7168ull * 1024, WOUT_E = WPOOL_E + 1024ull * 256, WFF1_E = WOUT_E + 1024ull * 1024, WFF2_E = WFF1_E + 4096ull * 1024, WB_E = WFF2_E + 4096ull * 1024;
constexpr size_t WS_SLOT0 = WB_E * 2;
constexpr size_t WS_HALO = WS_SLOT0 + 7 * SLOT * 2;
constexpr size_t WS_AB = WS_HALO + 512ull * 3 * 3072 * 2;
constexpr size_t WS_GTOT = WS_AB + (size_t)R * 16 * 4;
constexpr size_t WS_BAR = WS_GTOT + (size_t)NCHH * 4;
constexpr size_t WS_PART = WS_BAR + 3456 * 4;
constexpr size_t WS_END = WS_PART + 3ull * RS * 1024 * 4;
constexpr size_t O_POOLP = (size_t)R * 1024, O_CONVP = O_POOLP + 2ull * 8 * 15 * 1024, O_DELTAP = O_CONVP + 2ull * 8 * 3 * 3072,
                 O_POOLS = O_DELTAP + 2ull * 8 * 8 * 16384, O_CONVS = O_POOLS + 2ull * 16 * 15 * 1024, O_DELTAS = O_CONVS + 2ull * 16 * 3 * 3072;
constexpr int LDS_ST = 139264;
constexpr int LDS_BYTES = LDS_ST + 16;

struct Params {
    const float *x_prompt, *x_sample, *state_pool, *state_conv, *state_delta, *ln_in_g, *ln_in_b, *w_in, *conv_w, *a_log, *dt_bias, *o_gain, *w_pool, *pool_scale,
        *w_out, *ln1_g, *ln1_b, *w_ff1, *b_ff1, *w_ff2, *b_ff2, *ln2_g, *ln2_b;
    float* out;
    unsigned char* ws;
};

__device__ __forceinline__ int opaque_tid() { int t = threadIdx.x; asm volatile("" : "+v"(t)); return t; }
__device__ __forceinline__ float bf2f(bf16_t b) { return __uint_as_float(((unsigned)b) << 16); }
__device__ __forceinline__ bf16_t f2bf(float f) { const __bf16 b = (__bf16)f; return __builtin_bit_cast(unsigned short, b); }
typedef float f32x2_t __attribute__((ext_vector_type(2)));
typedef __bf16 bf16x2_t __attribute__((ext_vector_type(2)));
__device__ __forceinline__ unsigned cvt_pk_bf16(float lo, float hi) { const f32x2_t v = {lo, hi}; const bf16x2_t b = __builtin_convertvector(v, bf16x2_t); return __builtin_bit_cast(unsigned, b); }
__device__ __forceinline__ u32x4 pack8(f32x4 a, f32x4 b) { u32x4 o; o[0] = cvt_pk_bf16(a[0], a[1]); o[1] = cvt_pk_bf16(a[2], a[3]); o[2] = cvt_pk_bf16(b[0], b[1]); o[3] = cvt_pk_bf16(b[2], b[3]); return o; }
__device__ __forceinline__ void unpack8(u32x4 v, float (&o)[8]) {
#pragma unroll
    for (int i = 0; i < 4; ++i) { o[2 * i] = __uint_as_float(v[i] << 16); o[2 * i + 1] = __uint_as_float(v[i] & 0xffff0000u); }
}
__device__ __forceinline__ float sigm(float x) { return __builtin_amdgcn_rcpf(1.f + __expf(-x)); }
__device__ __forceinline__ float silu(float x) { return x * __builtin_amdgcn_rcpf(1.f + __expf(-x)); }
__device__ __forceinline__ float softplus(float x) { const float e = __expf(-fabsf(x)); const float lp = (e < 1e-3f) ? e * (1.f - 0.5f * e) : __logf(1.f + e); return fmaxf(x, 0.f) + lp; }
__device__ __forceinline__ float wave_sum(float v) {
#pragma unroll
    for (int o = 1; o < 64; o <<= 1) v += __shfl_xor(v, o);
    return v;
}
__device__ __forceinline__ f32x4 mfma16(bf16x8 a, bf16x8 b, f32x4 c) { return __builtin_amdgcn_mfma_f32_16x16x32_bf16(a, b, c, 0, 0, 0); }
__device__ __forceinline__ bf16_t* slotp(const Params& P, int i) { return (bf16_t*)(P.ws + WS_SLOT0) + (size_t)i * SLOT; }
__device__ __forceinline__ bf16_t* wbf(const Params& P) { return (bf16_t*)P.ws; }


#define XB_TMO      128
#define XB_XCNT(j)  (256  + 64 * (j))
#define XB_XSUB(j)  (1280 + 64 * (j))
#define XB_XGEN(j)  (2304 + 64 * (j))
#define XB_TOP      3328
#define XB_TOPGEN   3392
#define XCD_BAR_WORDS 3456
#define XB_SPIN_CAP (1u << 18)
__device__ __forceinline__ unsigned xb_ld(unsigned* p)              { return __hip_atomic_load(p, __ATOMIC_RELAXED, __HIP_MEMORY_SCOPE_AGENT); }
__device__ __forceinline__ unsigned xb_add(unsigned* p, unsigned v) { return __hip_atomic_fetch_add(p, v, __ATOMIC_RELAXED, __HIP_MEMORY_SCOPE_AGENT); }
__device__ __forceinline__ unsigned xb_xcc_id() { return (unsigned)__builtin_amdgcn_s_getreg((3 << 11) | 20) & 0xFu; }
#define XB_SPIN(cond, bar) do { unsigned _sp = 0; while (cond) { __builtin_amdgcn_s_sleep(1); \
    if ((++_sp & 255u) == 0u) { if (xb_ld(&(bar)[XB_TMO])) break; if (_sp > XB_SPIN_CAP) { atomicAdd(&(bar)[XB_TMO], 1u); break; } } } } while (0)
struct XcdBarrier { unsigned* bar; unsigned x; volatile LAS unsigned* st; };
__device__ __forceinline__ XcdBarrier xcd_barrier_post(unsigned* bar, volatile LAS unsigned* st) {
    XcdBarrier b; b.bar = bar; b.x = xb_xcc_id(); b.st = st;
    if (threadIdx.x == 0) (void)xb_add(&bar[XB_XCNT(b.x)], 1u);
    return b;
}
__device__ __forceinline__ void xcd_barrier_complete(unsigned* bar, unsigned x, unsigned& nloc, unsigned& nx) {
    const unsigned G = gridDim.x * gridDim.y * gridDim.z;
    unsigned sum, cnt, mine, sp = 0u;
    for (;;) {
        sum = 0u; cnt = 0u; mine = 0u;
#pragma unroll
        for (unsigned j = 0; j < 16; ++j) { const unsigned c = xb_ld(&bar[XB_XCNT(j)]); sum += c; cnt += (c > 0u) ? 1u : 0u; mine = (j == x) ? c : mine; }
        if (sum == G) break;
        __builtin_amdgcn_s_sleep(1);
        if ((++sp & 255u) == 0u) { if (xb_ld(&bar[XB_TMO])) break; if (sp > XB_SPIN_CAP) { atomicAdd(&bar[XB_TMO], 1u); break; } }
    }
    nloc = mine > 0u ? mine : 1u; nx = cnt > 0u ? cnt : 1u;
}
__device__ __forceinline__ void xcd_barrier(const XcdBarrier& b) {
    asm volatile("s_waitcnt vmcnt(0)" ::: "memory");
    __syncthreads();
    if (threadIdx.x == 0) {
        unsigned* bar = b.bar;
        __builtin_amdgcn_s_waitcnt(0);
        unsigned nloc = b.st[0], nx = b.st[1];
        if (nloc == 0u) { xcd_barrier_complete(bar, b.x, nloc, nx); b.st[0] = nloc; b.st[1] = nx; }
        const unsigned old = xb_add(&bar[XB_XSUB(b.x)], 1u);
        const unsigned gen = old / nloc;
        if (old + 1u == (gen + 1u) * nloc) {
            __builtin_amdgcn_fence(__ATOMIC_RELEASE, "agent");
            asm volatile("s_waitcnt vmcnt(0)" ::: "memory");
            const unsigned og = xb_add(&bar[XB_TOP], 1u);
            const unsigned tg = og / nx;
            if (og + 1u == (tg + 1u) * nx) xb_add(&bar[XB_TOPGEN], 1u);
            else XB_SPIN(xb_ld(&bar[XB_TOPGEN]) == tg, bar);
            __builtin_amdgcn_fence(__ATOMIC_ACQUIRE, "agent");
            xb_add(&bar[XB_XGEN(b.x)], 1u);
            asm volatile("s_waitcnt vmcnt(0)" ::: "memory");
        } else {
            XB_SPIN(xb_ld(&bar[XB_XGEN(b.x)]) == gen, bar);
            __builtin_amdgcn_fence(__ATOMIC_ACQUIRE, "agent");
            asm volatile("s_waitcnt vmcnt(0)" ::: "memory");
        }
    }
    __syncthreads();
}

namespace pg8 {
constexpr int BM = 256, BK = 64, HALF = 128, HTB = HALF * BK * 2, NXCD = 8, WGM = 8;
__device__ __forceinline__ int lds_byte(int r, int c) { const int st = (r >> 4) * 2 + (c >> 5), rr = r & 15, cc = c & 31, ob = rr * 64 + cc * 2; return st * 1024 + (ob ^ (((ob >> 9) & 1) << 5)); }
__device__ __forceinline__ void stage_rc(int b, int& Rr, int& C) { const int st = b / 1024, sb = b % 1024, swz = sb ^ (((sb >> 9) & 1) << 5); Rr = (st >> 1) * 16 + swz / 64; C = (st & 1) * 32 + (swz % 64) / 2; }
__device__ __forceinline__ int perm32(int rho) { const int n = rho >> 4, i = rho & 15; return 8 * (i >> 2) + 4 * n + (i & 3); }
struct Unit { int pm, pn, ks; };
struct Gemm { const bf16_t* A; const bf16_t* Bt; int M, N, K, lda, apn, ldb, nks; };
struct StaticOrder {
    int nM, nN, nwg, G, c;
    int nNr;
    __device__ void init(int M, int N, int nks, int G_, int c_) { nM = M / BM; nNr = N / BM; nN = nNr * nks; nwg = nM * nN; G = G_; c = c_; }
    __device__ bool next(int i, Unit& u) const {
        const long L = (long)i * G + c; if (L >= nwg) return false;
        int wgid = (int)L; { const int q = nwg / NXCD, r = nwg % NXCD, xcd = wgid % NXCD, off = wgid / NXCD; wgid = (xcd < r ? xcd * (q + 1) : r * (q + 1) + (xcd - r) * q) + off; }
        const int nig = WGM * nN, gid = wgid / nig, fm = gid * WGM, gsz = (nM - fm) < WGM ? (nM - fm) : WGM;
        u.pm = fm + ((wgid % nig) % gsz); const int pq = (wgid % nig) / gsz; u.pn = pq % nNr; u.ks = pq / nNr; return true;
    }
};
template <class Epi>
__device__ __forceinline__ void gemm_phase(LAS unsigned char* lds, const Gemm g, const StaticOrder& S, const Epi& E) {
    const int tid = opaque_tid(), wid = __builtin_amdgcn_readfirstlane(tid >> 6), lane = tid & 63, wr = wid >> 2, wc = wid & 3, fr = lane & 15, fq = lane >> 4;
    int K_ = g.K; asm volatile("" : "+s"(K_));
    const int K = K_, nt = K / BK, lda = g.lda;
    unsigned voffA[2], voffB[2];
#pragma unroll
    for (int i = 0; i < 2; ++i) { int Rr, C; stage_rc(tid * 16 + i * 8192, Rr, C); const int Rb = Epi::PERM ? ((Rr & ~31) + perm32(Rr & 31)) : Rr;
        voffA[i] = (unsigned)(Rr * lda + C) * 2u; voffB[i] = (unsigned)(Rb * g.ldb + C) * 2u; }
    const size_t kstep = (size_t)(BK * 2);
    const size_t hstepA = (size_t)HALF * lda * 2, hstepB = (size_t)HALF * g.ldb * 2, sstep = (size_t)K * 2;
    const size_t tstepA = 2 * hstepA, tstepB = 2 * hstepB;
    const unsigned ldsw = (unsigned)wid * 1024u;
    const int aoff = lds_byte(wr * 64 + fr, fq * 8), boff = lds_byte(wc * 32 + fr, fq * 8);
#define PG8_SA(b, h) (((b) * 2 + (h)) * HTB)
#define PG8_SB(b, h) ((4 + (b) * 2 + (h)) * HTB)
#define PG8_STAGE(bufoff, gbase, voff) do { _Pragma("unroll") for (int _i = 0; _i < 2; ++_i) \
        __builtin_amdgcn_global_load_lds((const unsigned*)((const char*)(gbase) + (voff)[_i]), (LAS unsigned*)(lds + (bufoff) + ldsw + _i * 8192), 16, 0, 0); } while (0)
#define PG8_LDA(dst, b, h) do { _Pragma("unroll") for (int m = 0; m < 4; ++m) _Pragma("unroll") for (int k = 0; k < 2; ++k) dst[m][k] = *(const LAS bf16x8*)(lds + PG8_SA(b, h) + aoff + m * 2048 + k * 1024); } while (0)
#define PG8_LDB(dst, b, h) do { _Pragma("unroll") for (int n = 0; n < 2; ++n) _Pragma("unroll") for (int k = 0; k < 2; ++k) dst[n][k] = *(const LAS bf16x8*)(lds + PG8_SB(b, h) + boff + n * 2048 + k * 1024); } while (0)
#define PG8_MMA(ai, bj, At, Bt) do { __builtin_amdgcn_s_setprio(1); _Pragma("unroll") for (int m = 0; m < 4; ++m) _Pragma("unroll") for (int n = 0; n < 2; ++n) _Pragma("unroll") for (int k = 0; k < 2; ++k) \
        acc[ai][bj][m][n] = __builtin_amdgcn_mfma_f32_16x16x32_bf16(Bt[n][k], At[m][k], acc[ai][bj][m][n], 0, 0, 0); __builtin_amdgcn_s_setprio(0); } while (0)
#define PG8_WAIT_V(n) asm volatile("s_waitcnt vmcnt(" #n ")" ::: "memory")
#define PG8_WAIT_L(n) asm volatile("s_waitcnt lgkmcnt(" #n ")" ::: "memory")
#define PG8_BAR __builtin_amdgcn_s_barrier()
#define PG8_SCHED __builtin_amdgcn_sched_barrier(0)
    Unit cur, nxt; int ui = 0;
    if (!S.next(0, cur)) return;
    f32x4 acc[2][2][4][2];
#pragma unroll
    for (int a = 0; a < 2; ++a)
#pragma unroll
        for (int b = 0; b < 2; ++b)
#pragma unroll
            for (int m = 0; m < 4; ++m)
#pragma unroll
                for (int n = 0; n < 2; ++n) acc[a][b][m][n] = (f32x4){0.f, 0.f, 0.f, 0.f};
    bf16x8 At[4][2], B0[2][2], B1[2][2];
    const char* cA = (const char*)g.A + (size_t)cur.pm * tstepA + (size_t)cur.pn * g.apn * 2 + (size_t)cur.ks * sstep; const char* cB = (const char*)g.Bt + (size_t)cur.pn * tstepB + (size_t)cur.ks * sstep;
    PG8_STAGE(PG8_SB(0, 0), cB, voffB); PG8_STAGE(PG8_SB(0, 1), cB + hstepB, voffB); PG8_STAGE(PG8_SA(0, 0), cA, voffA); PG8_STAGE(PG8_SA(0, 1), cA + hstepA, voffA);
    if (wr == 1) PG8_BAR;
    PG8_WAIT_V(2); PG8_BAR;
    PG8_STAGE(PG8_SB(1, 0), cB + kstep, voffB); PG8_STAGE(PG8_SA(1, 0), cA + kstep, voffA); PG8_STAGE(PG8_SB(1, 1), cB + hstepB + kstep, voffB);
    PG8_WAIT_V(6); PG8_BAR;
    for (;;) {
        const bool has_next = S.next(ui + 1, nxt);
        const char* nA = has_next ? (const char*)g.A + (size_t)nxt.pm * tstepA + (size_t)nxt.pn * g.apn * 2 + (size_t)nxt.ks * sstep : cA; const char* nB = has_next ? (const char*)g.Bt + (size_t)nxt.pn * tstepB + (size_t)nxt.ks * sstep : cB;
        for (int t = 0; t < nt; t += 2) {
            const bool last = (t == nt - 2);
            const char* a1 = cA + (size_t)(t + 1) * kstep;
            const char* a2 = last ? nA : cA + (size_t)(t + 2) * kstep; const char* b2 = last ? nB : cB + (size_t)(t + 2) * kstep;
            const char* a3 = a2 + kstep; const char* b3 = b2 + kstep;
            PG8_LDB(B0, 0, 0); PG8_LDB(B1, 0, 1); PG8_SCHED; PG8_LDA(At, 0, 0); PG8_STAGE(PG8_SA(1, 1), a1 + hstepA, voffA);
            PG8_WAIT_V(8); PG8_WAIT_L(0); PG8_BAR; PG8_MMA(0, 0, At, B0); PG8_MMA(0, 1, At, B1); PG8_BAR; PG8_SCHED;
            PG8_LDA(At, 0, 1); PG8_STAGE(PG8_SB(0, 0), b2, voffB); PG8_STAGE(PG8_SB(0, 1), b2 + hstepB, voffB); PG8_STAGE(PG8_SA(0, 0), a2, voffA);
            PG8_WAIT_V(8); PG8_WAIT_L(0); PG8_BAR; PG8_MMA(1, 0, At, B0); PG8_MMA(1, 1, At, B1); PG8_BAR; PG8_SCHED;
            PG8_LDB(B0, 1, 0); PG8_LDB(B1, 1, 1); PG8_SCHED; PG8_LDA(At, 1, 0); PG8_STAGE(PG8_SA(0, 1), a2 + hstepA, voffA);
            PG8_WAIT_V(8); PG8_WAIT_L(0); PG8_BAR; PG8_MMA(0, 0, At, B0); PG8_MMA(0, 1, At, B1); PG8_BAR; PG8_SCHED;
            PG8_LDA(At, 1, 1); PG8_STAGE(PG8_SB(1, 0), b3, voffB); PG8_STAGE(PG8_SB(1, 1), b3 + hstepB, voffB); PG8_STAGE(PG8_SA(1, 0), a3, voffA);
            PG8_WAIT_V(8); PG8_WAIT_L(0); PG8_BAR; PG8_MMA(1, 0, At, B0); PG8_MMA(1, 1, At, B1); PG8_BAR; PG8_SCHED;
        }
        if (wr == 0) PG8_BAR;
        E(acc, cur, wr, wc, fr, fq);
        if (!has_next) break;
#pragma unroll
        for (int a = 0; a < 2; ++a)
#pragma unroll
            for (int b = 0; b < 2; ++b)
#pragma unroll
                for (int m = 0; m < 4; ++m)
#pragma unroll
                    for (int n = 0; n < 2; ++n) acc[a][b][m][n] = (f32x4){0.f, 0.f, 0.f, 0.f};
        cur = nxt; cA = nA; cB = nB; ++ui;
        if (wr == 1) PG8_BAR;
    }
    PG8_WAIT_V(0);
    PG8_BAR;
#undef PG8_SA
#undef PG8_SB
#undef PG8_STAGE
#undef PG8_LDA
#undef PG8_LDB
#undef PG8_MMA
#undef PG8_WAIT_V
#undef PG8_WAIT_L
#undef PG8_BAR
#undef PG8_SCHED
}
}
using pg8::Unit;
typedef f32x4 Acc[2][2][4][2];

struct EpiIn {
    static constexpr bool PERM = true;
    bf16_t *up, *q, *z, *ga; bf16_t* halo; float *pool_p, *conv_p, *pool_s, *conv_s;
    __device__ __forceinline__ void operator()(const Acc& acc, const Unit& u, int wr, int wc, int fr, int fq) const {
        const int t = u.pn >> 2;
        const int csb = (u.pn & 3) * 256 + wc * 32 + 8 * fq;
        const bool smp = u.pm >= 128;
        const bool lastp = !smp && (u.pm & 15) == 15;
#pragma unroll
        for (int ai = 0; ai < 2; ++ai)
#pragma unroll
            for (int m = 0; m < 4; ++m) {
                const int r = u.pm * 256 + ai * 128 + wr * 64 + m * 16 + fr;
                const int rs = r - RP;
#pragma unroll
                for (int bj = 0; bj < 2; ++bj) {
                    const int cs = csb + bj * 128;
                    const f32x4 v0 = acc[ai][bj][m][0], v1 = acc[ai][bj][m][1];
                    const u32x4 pk = pack8(v0, v1);
                    if (t == 0) {
                        *(u32x4*)(up + (size_t)r * 1024 + cs) = pk;
                        if (m == 3 && ai == 1 && lastp && wr == 1 && fr >= 1) {
                            float* so = pool_p + ((size_t)((r >> 12) * 15 + ((r & 4095) - 4081))) * 1024 + cs; *(f32x4*)so = v0; *(f32x4*)(so + 4) = v1; }
                        if ((m & 1) && smp && fr >= 1) {
                            float* so = pool_s + ((size_t)((rs >> 5) * 15 + ((rs & 31) - 17))) * 1024 + cs; *(f32x4*)so = v0; *(f32x4*)(so + 4) = v1; }
                    } else if (t <= 3) {
                        const int h = cs >> 7, c = cs & 127;
                        const size_t blk = smp ? ((size_t)((512 + (rs >> 5)) * 8 + h) * 64 + (rs & 31)) : ((size_t)((r >> 6) * 8 + h) * 64 + (r & 63));
                        *(u32x4*)(q + (size_t)(t - 1) * SLOT + blk * 128 + c) = pk;
                        const int cc = (t - 1) * 1024 + cs;
                        if (m == 3 && !smp && fr >= 13) {
                            const int chunk = r >> 6, i3 = (r & 63) - 61;
                            if ((chunk & 63) == 63) { float* so = conv_p + ((size_t)((r >> 12) * 3 + i3)) * 3072 + cc; *(f32x4*)so = v0; *(f32x4*)(so + 4) = v1; }
                            else *(u32x4*)(halo + ((size_t)(chunk + 1) * 3 + i3) * 3072 + cc) = pk;
                        }
                        if ((m & 1) && smp && fr >= 13) {
                            float* so = conv_s + ((size_t)((rs >> 5) * 3 + ((rs & 31) - 29))) * 3072 + cc; *(f32x4*)so = v0; *(f32x4*)(so + 4) = v1; }
                    } else if (t == 4) {
                        *(u32x4*)(z + (size_t)r * 1024 + cs) = pk;
                    } else {
                        *(u32x4*)(ga + (size_t)(t - 5) * R * 1024 + (size_t)r * 1024 + cs) = pk;
                    }
                }
            }
    }
};
struct EpiPool {
    static constexpr bool PERM = true;
    bf16_t* ga; const float* scale;
    __device__ __forceinline__ void operator()(const Acc& acc, const Unit& u, int wr, int wc, int fr, int fq) const {
        const int rb = u.pm * 256 + wr * 64 + fr, cb = u.pn * 256 + wc * 32 + 8 * fq;
        u32x4 gas[2][4];
        auto ldgrp = [&](int g, int slot) __attribute__((always_inline)) {
            const int c = cb + (g >> 1) * 128, ai = g & 1;
#pragma unroll
            for (int m = 0; m < 4; ++m) gas[slot][m] = *(const u32x4*)(ga + (size_t)(rb + ai * 128 + m * 16) * 1024 + c);
        };
        f32x4 sc[2][2];
#pragma unroll
        for (int bj = 0; bj < 2; ++bj) { sc[bj][0] = *(const f32x4*)(scale + cb + bj * 128); sc[bj][1] = *(const f32x4*)(scale + cb + bj * 128 + 4); }
        ldgrp(0, 0);
#pragma unroll
        for (int g = 0; g < 4; ++g) {
            const int slot = g & 1, bj = g >> 1, ai = g & 1;
            if (g + 1 < 4) ldgrp(g + 1, slot ^ 1);
            const int c = cb + bj * 128;
#pragma unroll
            for (int m = 0; m < 4; ++m) {
                float gv[8]; unpack8(gas[slot][m], gv);
                f32x4 v0 = acc[ai][bj][m][0], v1 = acc[ai][bj][m][1];
#pragma unroll
                for (int e = 0; e < 4; ++e) { v0[e] = sigm(gv[e]) * sc[bj][0][e] * v0[e]; v1[e] = sigm(gv[4 + e]) * sc[bj][1][e] * v1[e]; }
                *(u32x4*)(ga + (size_t)(rb + ai * 128 + m * 16) * 1024 + c) = pack8(v0, v1);
            }
        }
    }
};
struct EpiRes {
    static constexpr bool PERM = true;
    const bf16_t* res; const float* bias; bf16_t* out; float* part;
    __device__ __forceinline__ void operator()(const Acc& acc, const Unit& u, int wr, int wc, int fr, int fq) const {
        const int rb = u.pm * 256 + wr * 64 + fr, cb = u.pn * 256 + wc * 32 + 8 * fq;
        if (u.ks > 0) {
#pragma unroll
            for (int bj = 0; bj < 2; ++bj)
#pragma unroll
                for (int n = 0; n < 2; ++n)
#pragma unroll
                    for (int ai = 0; ai < 2; ++ai)
#pragma unroll
                        for (int m = 0; m < 4; ++m) *(f32x4*)(part + ((size_t)(u.ks - 1) * RS + rb + ai * 128 + m * 16) * 1024 + cb + bj * 128 + 4 * n) = acc[ai][bj][m][n];
            return;
        }
        u32x4 rv[2][4]; f32x4 bv[2][2];
#pragma unroll
        for (int bj = 0; bj < 2; ++bj)
#pragma unroll
            for (int n = 0; n < 2; ++n) bv[bj][n] = bias ? *(const f32x4*)(bias + cb + bj * 128 + 4 * n) : (f32x4){0.f, 0.f, 0.f, 0.f};
        auto ldgrp = [&](int g, int slot) __attribute__((always_inline)) {
            const int c = cb + (g >> 1) * 128, ai = g & 1;
#pragma unroll
            for (int m = 0; m < 4; ++m) rv[slot][m] = *(const u32x4*)(res + (size_t)(rb + ai * 128 + m * 16) * 1024 + c);
        };
        ldgrp(0, 0);
#pragma unroll
        for (int g = 0; g < 4; ++g) {
            const int slot = g & 1, bj = g >> 1, ai = g & 1;
            if (g + 1 < 4) ldgrp(g + 1, slot ^ 1);
            const int c = cb + bj * 128;
#pragma unroll
            for (int m = 0; m < 4; ++m) {
                float x[8]; unpack8(rv[slot][m], x);
                f32x4 o0 = acc[ai][bj][m][0] + bv[bj][0], o1 = acc[ai][bj][m][1] + bv[bj][1];
#pragma unroll
                for (int e = 0; e < 4; ++e) { o0[e] += ALPHA * x[e]; o1[e] += ALPHA * x[4 + e]; }
                *(u32x4*)(out + (size_t)(rb + ai * 128 + m * 16) * 1024 + c) = pack8(o0, o1);
            }
        }
    }
};
struct EpiFF1 {
    static constexpr bool PERM = true;
    bf16_t* h; const float* bias;
    __device__ __forceinline__ void operator()(const Acc& acc, const Unit& u, int wr, int wc, int fr, int fq) const {
        f32x4 bb[2][2];
#pragma unroll
        for (int bj = 0; bj < 2; ++bj) { const int c = u.pn * 256 + bj * 128 + wc * 32 + 8 * fq; bb[bj][0] = *(const f32x4*)(bias + c); bb[bj][1] = *(const f32x4*)(bias + c + 4); }
#pragma unroll
        for (int bj = 0; bj < 2; ++bj) {
            const int c = u.pn * 256 + bj * 128 + wc * 32 + 8 * fq;
            const f32x4 b0 = bb[bj][0], b1 = bb[bj][1];
#pragma unroll
            for (int ai = 0; ai < 2; ++ai)
#pragma unroll
                for (int m = 0; m < 4; ++m) {
                    const int r = u.pm * 256 + ai * 128 + wr * 64 + m * 16 + fr;
                    f32x4 v0 = acc[ai][bj][m][0] + b0, v1 = acc[ai][bj][m][1] + b1;
#pragma unroll
                    for (int e = 0; e < 4; ++e) { const float a = fmaxf(v0[e], 0.f), b = fmaxf(v1[e], 0.f); v0[e] = a * a; v1[e] = b * b; }
                    *(u32x4*)(h + (size_t)r * DFF + c) = pack8(v0, v1);
                }
        }
    }
};
template <class Epi> __device__ __forceinline__ void run_gemm(LAS unsigned char* lds, const bf16_t* A, int lda, int apn, const bf16_t* Bt, int M, int N, int K, const Epi& E, int nks = 1) {
    pg8::Gemm g; g.A = A; g.Bt = Bt; g.M = M; g.N = N; g.K = K / nks; g.lda = lda; g.apn = apn; g.ldb = K; g.nks = nks;
    pg8::StaticOrder S; S.init(M, N, nks, (int)gridDim.x, (int)*(volatile LAS unsigned*)(lds + LDS_ST + 8));
    pg8::gemm_phase<Epi>(lds, g, S, E);
}

struct TileRef { const float* src; bf16_t* dst; int ld_src, ld_dst; };
__device__ __forceinline__ TileRef weight_tile(const Params& P, int l, int it) {
    bf16_t* wb = wbf(P); TileRef t; int kb, nb;
    if (it < 1792) { kb = it / 112; nb = it % 112; t.src = P.w_in + (size_t)l * 1024 * INW; t.ld_src = INW; t.dst = wb + WIN_E; t.ld_dst = 1024; }
    else if (it < 1856) { const int j = it - 1792, g = j >> 4; kb = (j >> 2) & 3; nb = j & 3; t.src = P.w_pool + ((size_t)l * 4 + g) * 65536; t.ld_src = 256; t.dst = wb + WPOOL_E + (size_t)g * 65536; t.ld_dst = 256; }
    else if (it < 2112) { const int j = it - 1856; kb = j >> 4; nb = j & 15; t.src = P.w_out + (size_t)l * 1048576; t.ld_src = 1024; t.dst = wb + WOUT_E; t.ld_dst = 1024; }
    else if (it < 3136) { const int j = it - 2112; kb = j >> 6; nb = j & 63; t.src = P.w_ff1 + (size_t)l * 4194304; t.ld_src = 4096; t.dst = wb + WFF1_E; t.ld_dst = 1024; }
    else { const int j = it - 3136; kb = j >> 4; nb = j & 15; t.src = P.w_ff2 + (size_t)l * 4194304; t.ld_src = 1024; t.dst = wb + WFF2_E; t.ld_dst = 4096; }
    t.src += (size_t)(kb * 64) * t.ld_src + nb * 64; t.dst += (size_t)(nb * 64) * t.ld_dst + kb * 64;
    return t;
}
__device__ __forceinline__ void convert_weights(const Params& P, int l, LAS unsigned char* lds) {
    LAS float* t = (LAS float*)lds;
    const int tid = opaque_tid();
    const int kk0 = tid >> 4, n4 = (tid & 15) * 4, G = (int)gridDim.x;
    f32x4 preA[2], preB[2], preC[2];
    auto ldt = [&](int it, f32x4 (&pre)[2]) __attribute__((always_inline)) {
        if (it < 4160) { const TileRef T = weight_tile(P, l, it);
#pragma unroll
            for (int p = 0; p < 2; ++p) pre[p] = *(const f32x4*)(T.src + (size_t)(kk0 + 32 * p) * T.ld_src + n4); }
    };
    auto doit = [&](int it, const f32x4 (&pre)[2]) __attribute__((always_inline)) {
        const TileRef T = weight_tile(P, l, it);
#pragma unroll
        for (int p = 0; p < 2; ++p) { const int kk = kk0 + 32 * p; t[kk * 65 + n4] = pre[p][0]; t[kk * 65 + n4 + 1] = pre[p][1]; t[kk * 65 + n4 + 2] = pre[p][2]; t[kk * 65 + n4 + 3] = pre[p][3]; }
        __syncthreads();
        { const int n = tid >> 3, k8 = (tid & 7) * 8; u32x4 o;
#pragma unroll
          for (int e = 0; e < 4; ++e) o[e] = cvt_pk_bf16(t[(k8 + 2 * e) * 65 + n], t[(k8 + 2 * e + 1) * 65 + n]);
          *(u32x4*)(T.dst + (size_t)n * T.ld_dst + k8) = o; }
        __syncthreads();
    };
    int it = blockIdx.x;
    ldt(it, preA); ldt(it + G, preB); ldt(it + 2 * G, preC);
    while (it < 4160) {
        doit(it, preA); ldt(it + 3 * G, preA); it += G; if (it >= 4160) break;
        doit(it, preB); ldt(it + 3 * G, preB); it += G; if (it >= 4160) break;
        doit(it, preC); ldt(it + 3 * G, preC); it += G;
    }
}

template <int N> __device__ __forceinline__ float reduce_scatter(float (&v)[N], int lane);
__device__ __forceinline__ int bitrev(int x, int bits);
__device__ __forceinline__ void ln_phase(const Params& P, const float* src0, const float* src1, const float* g, const float* b, bf16_t* xb, float* yf, int wl, LAS unsigned char* lds, const float* part = nullptr, const bf16_t* srcb = nullptr) {
    LAS float* wt = (LAS float*)lds;
    const int tid = opaque_tid(), lane = tid & 63, wid = tid >> 6;
    if (wl >= 0) {
        const float* w16 = P.w_in + (size_t)wl * 1024 * INW + 7168;
        for (int i = tid; i < 1024 * 4; i += 512) { const int k = i >> 2, j4 = (i & 3) * 4; const f32x4 v = *(const f32x4*)(w16 + (size_t)k * INW + j4);
            const int kk = ((k >> 8) * 4 + (k & 3)) * 64 + ((k >> 2) & 63); *(LAS f32x4*)(wt + kk * 16 + j4) = v; }
        __syncthreads();
    }
    f32x4 gv[4], bv[4];
#pragma unroll
    for (int j = 0; j < 4; ++j) { gv[j] = *(const f32x4*)(g + lane * 4 + 256 * j); bv[j] = *(const f32x4*)(b + lane * 4 + 256 * j); }
    float* ab = (float*)(P.ws + WS_AB);
    const int rstride = gridDim.x * 8;
    f32x4 vn[4], vn2[4];
    auto ldrow = [&](int rr, f32x4 (&d)[4]) __attribute__((always_inline)) {
        if (rr < R) {
            if (srcb) {
#pragma unroll
                for (int j = 0; j < 4; ++j) { const u32x2 t = *(const u32x2*)(srcb + (size_t)rr * 1024 + lane * 4 + 256 * j);
                    d[j][0] = __uint_as_float(t[0] << 16); d[j][1] = __uint_as_float(t[0] & 0xffff0000u); d[j][2] = __uint_as_float(t[1] << 16); d[j][3] = __uint_as_float(t[1] & 0xffff0000u); }
            } else { const float* xr = (rr < RP) ? src0 + (size_t)rr * 1024 : src1 + (size_t)(rr - RP) * 1024;
#pragma unroll
                for (int j = 0; j < 4; ++j) d[j] = *(const f32x4*)(xr + lane * 4 + 256 * j); }
        }
    };
    ldrow(blockIdx.x * 8 + wid, vn); ldrow(blockIdx.x * 8 + wid + rstride, vn2);
    for (int r = blockIdx.x * 8 + wid; r < R; r += rstride) {
        f32x4 v[4]; float s = 0.f;
#pragma unroll
        for (int j = 0; j < 4; ++j) { v[j] = vn[j]; vn[j] = vn2[j]; }
        ldrow(r + 2 * rstride, vn2);
        if (part && r >= RP) {
#pragma unroll
            for (int q = 0; q < 3; ++q)
#pragma unroll
                for (int j = 0; j < 4; ++j) v[j] = v[j] + *(const f32x4*)(part + ((size_t)q * RS + (r - RP)) * 1024 + lane * 4 + 256 * j);
        }
#pragma unroll
        for (int j = 0; j < 4; ++j) s += (v[j][0] + v[j][1]) + (v[j][2] + v[j][3]);
        const float mean = wave_sum(s) * (1.f / 1024.f); float s2 = 0.f;
#pragma unroll
        for (int j = 0; j < 4; ++j) { v[j] = v[j] - mean; s2 += (v[j][0] * v[j][0] + v[j][1] * v[j][1]) + (v[j][2] * v[j][2] + v[j][3] * v[j][3]); }
        const float rstd = rsqrtf(wave_sum(s2) * (1.f / 1024.f) + 1e-5f);
#pragma unroll
        for (int j = 0; j < 4; ++j) v[j] = v[j] * rstd * gv[j] + bv[j];
        if (xb) {
#pragma unroll
            for (int j = 0; j < 4; ++j) { u32x2 o; o[0] = cvt_pk_bf16(v[j][0], v[j][1]); o[1] = cvt_pk_bf16(v[j][2], v[j][3]); *(u32x2*)(xb + (size_t)r * 1024 + lane * 4 + 256 * j) = o; }
        }
        if (yf) {
#pragma unroll
            for (int j = 0; j < 4; ++j) *(f32x4*)(yf + (size_t)r * 1024 + lane * 4 + 256 * j) = v[j];
        }
        if (wl >= 0) {
            f32x4 pv[4];
#pragma unroll
            for (int q = 0; q < 4; ++q) pv[q] = (f32x4){0.f, 0.f, 0.f, 0.f};
#pragma unroll
            for (int j = 0; j < 4; ++j)
#pragma unroll
                for (int e = 0; e < 4; ++e) {
                    const LAS f32x4* wp = (const LAS f32x4*)(wt + ((j * 4 + e) * 64 + lane) * 16);
                    const float xv = v[j][e];
#pragma unroll
                    for (int q4 = 0; q4 < 4; ++q4) pv[q4] = pv[q4] + wp[q4] * xv;
                    if (e == 3) __builtin_amdgcn_sched_barrier(0);
                }
            float p[16];
#pragma unroll
            for (int q = 0; q < 16; ++q) p[q] = pv[q >> 2][q & 3];
            float ov = reduce_scatter<16>(p, lane);
            ov += __shfl_xor(ov, 16); ov += __shfl_xor(ov, 32);
            if (lane < 16) ab[(size_t)r * 16 + bitrev(lane, 4)] = ov;
        }
    }
}

__device__ __forceinline__ void mixed_phase(const Params& P, int l) {
    const bf16_t* up = slotp(P, 1); bf16_t* mx = slotp(P, 6);
    const int nitems = (1024 + 16) * 128;
    for (int idx = blockIdx.x * 512 + opaque_tid(); idx < nitems; idx += gridDim.x * 512) {
        const int blk = idx >> 7, c = (idx & 127) * 8;
        int rbase, t0, sb; bool smp;
        if (blk < 1024) { rbase = (blk >> 7) * 4096; t0 = (blk & 127) * 32; smp = false; sb = 0; }
        else { sb = blk - 1024; rbase = RP + sb * 32; t0 = 0; smp = true; }
        const int w = 2 << (c >> 8);
        const float* hist = P.state_pool + ((size_t)(l * 16 + sb) * 15) * 1024 + c;
        auto ldu = [&](int t, float (&o)[8]) __attribute__((always_inline)) {
            if (t >= 0) { unpack8(*(const u32x4*)(up + (size_t)(rbase + t) * 1024 + c), o); }
            else if (smp) { const f32x4 a = *(const f32x4*)(hist + (size_t)(15 + t) * 1024), b2 = *(const f32x4*)(hist + (size_t)(15 + t) * 1024 + 4);
#pragma unroll
                for (int e = 0; e < 4; ++e) { o[e] = a[e]; o[4 + e] = b2[e]; } }
            else {
#pragma unroll
                for (int e = 0; e < 8; ++e) o[e] = 0.f; }
        };
        float s[8];
#pragma unroll
        for (int e = 0; e < 8; ++e) s[e] = 0.f;
        for (int d0 = 1; d0 < w; d0 += 4) {
            float hb[4][8];
#pragma unroll
            for (int q = 0; q < 4; ++q) { if (d0 + q < w) ldu(t0 - d0 - q, hb[q]); else {
#pragma unroll
                for (int e = 0; e < 8; ++e) hb[q][e] = 0.f; } }
#pragma unroll
            for (int q = 0; q < 4; ++q)
#pragma unroll
                for (int e = 0; e < 8; ++e) s[e] += hb[q][e];
        }
        float cur[4][8], old[4][8], ncur[4][8], nold[4][8];
#pragma unroll
        for (int q = 0; q < 4; ++q) { ldu(t0 + q, cur[q]); ldu(t0 + q - w + 1, old[q]); }
#pragma unroll
        for (int i0 = 0; i0 < 32; i0 += 4) {
            if (i0 + 4 < 32) {
#pragma unroll
                for (int q = 0; q < 4; ++q) { ldu(t0 + i0 + 4 + q, ncur[q]); ldu(t0 + i0 + 4 + q - w + 1, nold[q]); }
            }
#pragma unroll
            for (int q = 0; q < 4; ++q) {
                const int i = i0 + q;
                const float inv = 1.f / (smp ? (float)w : (float)min(w, t0 + i + 1));
                f32x4 o0, o1;
#pragma unroll
                for (int e = 0; e < 8; ++e) s[e] += cur[q][e];
#pragma unroll
                for (int e = 0; e < 4; ++e) { o0[e] = s[e] * inv - cur[q][e]; o1[e] = s[4 + e] * inv - cur[q][4 + e]; }
                *(u32x4*)(mx + (size_t)(rbase + t0 + i) * 1024 + c) = pack8(o0, o1);
#pragma unroll
                for (int e = 0; e < 8; ++e) s[e] -= old[q][e];
            }
#pragma unroll
            for (int q = 0; q < 4; ++q)
#pragma unroll
                for (int e = 0; e < 8; ++e) { cur[q][e] = ncur[q][e]; old[q][e] = nold[q][e]; }
        }
    }
}

template <int N> __device__ __forceinline__ float reduce_scatter(float (&v)[N], int lane) {
    int n = N;
#pragma unroll
    for (int s = 0; (1 << s) < N; ++s) {
        const unsigned mk = ((lane >> s) & 1) ? 0xffffffffu : 0u; const int hn = n >> 1;
#pragma unroll
        for (int j = 0; j < (N >> (s + 1)); ++j) { const unsigned ua = __float_as_uint(v[j]), ub = __float_as_uint(v[j + hn]);
            const float send = __uint_as_float((ua & mk) | (ub & ~mk)); const float keep = __uint_as_float((ub & mk) | (ua & ~mk)); v[j] = keep + __shfl_xor(send, 1 << s); }
        n = hn;
    }
    return v[0];
}
__device__ __forceinline__ int bitrev(int x, int bits) { int r = 0; for (int i = 0; i < bits; ++i) r |= ((x >> i) & 1) << (bits - 1 - i); return r; }

#define P2_BAR() asm volatile("s_waitcnt lgkmcnt(0)\n\ts_barrier" ::: "memory")
__device__ __forceinline__ void delta_pre_phase(const Params& P, int l, LAS unsigned char* lds0) {
    const int tid = opaque_tid(), half = tid >> 8, th0 = tid & 255;
    LAS unsigned char* lds = lds0 + half * 65536;
    LAS float* Lf = (LAS float*)lds;
    LAS bf16_t* kb = (LAS bf16_t*)(lds + 16384);
    LAS bf16_t* qb = (LAS bf16_t*)(lds + 33792);
    LAS float* gc = (LAS float*)(lds + 55296);
    LAS float* be = gc + 64; LAS float* eg = gc + 128; LAS float* rnk = gc + 192; LAS float* rnq = gc + 256;
    LAS float* red = gc + 320;
    const bf16_t* halo = (const bf16_t*)(P.ws + WS_HALO);
    const float* ab = (const float*)(P.ws + WS_AB);
    float* gtot = (float*)(P.ws + WS_GTOT);
    bf16_t* qs = slotp(P, 2); bf16_t* ks = slotp(P, 3); bf16_t* vs = slotp(P, 4); bf16_t* ws_ = slotp(P, 1); bf16_t* ats = slotp(P, 6);
    const float* cw = P.conv_w + (size_t)l * 4 * 3072;
    for (int pair = blockIdx.x; pair < NCHH / 2; pair += gridDim.x) {
        int th = th0; asm volatile("" : "+v"(th));
        const int wv4 = th >> 6, lane = th & 63;
        const int ch = pair * 2 + half;
        const bool smp = ch >= 4096;
        const int chunk = ch >> 3, h = ch & 7, sb = smp ? chunk - 512 : 0, n = chunk & 63;
        const int r0 = smp ? RP + sb * 32 : chunk * 64, nvalid = smp ? 32 : 64;
        bf16_t* qblk = qs + (size_t)ch * 8192; bf16_t* kblk = ks + (size_t)ch * 8192; bf16_t* vblk = vs + (size_t)ch * 8192;
        if (wv4 == 0) {
            const bool valid = lane < nvalid; const int r = r0 + (valid ? lane : 0);
            const float braw = ab[(size_t)r * 16 + h], araw = ab[(size_t)r * 16 + 8 + h];
            const float beta = valid ? sigm(braw) : 0.f;
            float gg = valid ? -__expf(P.a_log[l * 8 + h]) * softplus(araw + P.dt_bias[l * 8 + h]) : 0.f;
#pragma unroll
            for (int d = 1; d < 64; d <<= 1) { const float o = __shfl_up(gg, d); if (lane >= d) gg += o; }
            gc[lane] = gg; be[lane] = beta; eg[lane] = __expf(gg); rnk[lane] = __expf(__shfl(gg, 63) - gg);
            if (lane == 63) gtot[ch] = __expf(gg);
        }
        const int col = th & 127;
        const float* sconv = P.state_conv + (size_t)(l * 16 + sb) * 3 * 3072;
        auto halo_val = [&](int sec, int hi) __attribute__((always_inline)) -> float {
            const int cc = sec * 1024 + h * 128 + col;
            if (smp) return sconv[(size_t)hi * 3072 + cc];
            if (n == 0) return 0.f;
            return bf2f(halo[((size_t)chunk * 3 + hi) * 3072 + cc]);
        };
        const int rh = th >> 7;
        LAS float* rk = gc + 256; LAS float* rq = gc + 320;
        float qx[32], x[64];
        {
            const int ccq = h * 128 + col, sec = (th < 128) ? 1 : 2, cck = sec * 1024 + h * 128 + col;
            const float qw0 = cw[ccq], qw1 = cw[3072 + ccq], qw2 = cw[2 * 3072 + ccq], qw3 = cw[3 * 3072 + ccq];
            const float kw0 = cw[cck], kw1 = cw[3072 + cck], kw2 = cw[2 * 3072 + cck], kw3 = cw[3 * 3072 + cck];
            float qm3, qm2, qm1;
            if (rh == 0) { qm3 = halo_val(0, 0); qm2 = halo_val(0, 1); qm1 = halo_val(0, 2); }
            else { qm3 = bf2f(qblk[29 * 128 + col]); qm2 = bf2f(qblk[30 * 128 + col]); qm1 = bf2f(qblk[31 * 128 + col]); }
            float km3 = halo_val(sec, 0), km2 = halo_val(sec, 1), km1 = halo_val(sec, 2);
            const GAS bf16_t* pq = (const GAS bf16_t*)(qblk + (rh * 32) * 128 + col);
            const GAS bf16_t* pk = (const GAS bf16_t*)((th < 128 ? kblk : vblk) + col);
#pragma unroll
            for (int i = 0; i < 32; ++i) qx[i] = bf2f(pq[i * 128]);
#pragma unroll
            for (int i = 0; i < 64; ++i) x[i] = bf2f(pk[i * 128]);
            if (smp) {
                const int nv = nvalid - rh * 32;
#pragma unroll
                for (int i = 0; i < 32; ++i) qx[i] = (i < nv) ? qx[i] : 0.f;
#pragma unroll
                for (int i = 0; i < 64; ++i) x[i] = (i < nvalid) ? x[i] : 0.f;
            }
#pragma unroll
            for (int i = 0; i < 32; ++i) { const float x0 = qx[i];
                const float y = qw0 * qm3 + qw1 * qm2 + qw2 * qm1 + qw3 * x0; const float sv = silu(y); qx[i] = sv; qb[(rh * 32 + i) * 136 + col] = f2bf(sv); qm3 = qm2; qm2 = qm1; qm1 = x0; }
#pragma unroll
            for (int i = 0; i < 64; ++i) { const float x0 = x[i];
                const float y = kw0 * km3 + kw1 * km2 + kw2 * km1 + kw3 * x0; x[i] = silu(y); km3 = km2; km2 = km1; km1 = x0; }
        }
        if (th < 128) {
#pragma unroll
            for (int i = 0; i < 64; ++i) kb[i * 136 + col] = f2bf(x[i]);
        }
        P2_BAR();
        const int m = wv4, ln = lane & 15, lq = lane >> 4;
        f32x4 aL[4], aA[4];
        {
            f32x4 aQ = (f32x4){0.f, 0.f, 0.f, 0.f};
            bf16x8 ak[4], aq[4];
#pragma unroll
            for (int ksx = 0; ksx < 4; ++ksx) { const int ko = 32 * ksx + lq * 8;
                ak[ksx] = *(const LAS bf16x8*)(kb + (16 * m + ln) * 136 + ko); aq[ksx] = *(const LAS bf16x8*)(qb + (16 * m + ln) * 136 + ko); }
#pragma unroll
            for (int ksx = 0; ksx < 4; ++ksx) aQ = mfma16(aq[ksx], aq[ksx], aQ);
#pragma unroll
            for (int nn = 0; nn < 4; ++nn) {
                aL[nn] = (f32x4){0.f, 0.f, 0.f, 0.f}; aA[nn] = (f32x4){0.f, 0.f, 0.f, 0.f};
                if (nn <= m) {
#pragma unroll
                    for (int ksx = 0; ksx < 4; ++ksx) {
                        const bf16x8 bk = *(const LAS bf16x8*)(kb + (16 * nn + ln) * 136 + 32 * ksx + lq * 8);
                        aL[nn] = mfma16(ak[ksx], bk, aL[nn]); aA[nn] = mfma16(bk, aq[ksx], aA[nn]);
                    }
                }
                if (nn == m && (ln >> 2) == lq) {
                    const int rg = ln & 3;
                    const float gk = rg == 0 ? aL[nn][0] : rg == 1 ? aL[nn][1] : rg == 2 ? aL[nn][2] : aL[nn][3];
                    const float gq = rg == 0 ? aQ[0] : rg == 1 ? aQ[1] : rg == 2 ? aQ[2] : aQ[3];
                    rk[16 * m + ln] = rsqrtf(gk + 1e-6f); rq[16 * m + ln] = rsqrtf(gq + 1e-6f) * 0.08838834764831845f;
                }
            }
        }
        P2_BAR();
        {
            bf16_t* at = ats + (size_t)ch * 4096;
#pragma unroll
            for (int nn = 0; nn < 4; ++nn) {
                const int j = 16 * nn + ln; const float gj = gc[j], rkj = rk[j];
#pragma unroll
                for (int rg = 0; rg < 4; ++rg) {
                    const int i = 16 * m + lq * 4 + rg;
                    const float d = (i >= j) ? __expf(gc[i] - gj) * rkj : 0.f;
                    Lf[i * 64 + (j & 3) * 16 + (j >> 2)] = (i > j) ? be[i] * rk[i] * aL[nn][rg] * d : 0.f;
                }
                {
                    const int i2 = 16 * m + ln, j2 = 16 * nn + 4 * lq; const float gi = gc[i2], rqi = rq[i2];
                    float av[4];
#pragma unroll
                    for (int rg = 0; rg < 4; ++rg) av[rg] = (i2 >= j2 + rg) ? rqi * aA[nn][rg] * __expf(gi - gc[j2 + rg]) * rk[j2 + rg] : 0.f;
                    u32x2 o; o[0] = cvt_pk_bf16(av[0], av[1]); o[1] = cvt_pk_bf16(av[2], av[3]);
                    *(u32x2*)(at + i2 * 64 + j2) = o;
                }
            }
        }
        if (th < 128) {
            u32x4 o[8];
#pragma unroll
            for (int i = 0; i < 64; i += 2) {
                const float k0 = x[i] * rk[i], k1 = x[i + 1] * rk[i + 1];
                o[i >> 3][(i >> 1) & 3] = cvt_pk_bf16(k0 * rnk[i], k1 * rnk[i + 1]);
                x[i] = k0 * be[i] * eg[i]; x[i + 1] = k1 * be[i + 1] * eg[i + 1];
            }
#pragma unroll
            for (int e = 0; e < 8; ++e) *(u32x4*)(kblk + col * 64 + e * 8) = o[e];
        } else {
#pragma unroll
            for (int i = 0; i < 64; ++i) x[i] *= be[i];
        }
        {
#pragma unroll
            for (int e = 0; e < 4; ++e) {
                const int pc = th + 256 * e, row = pc >> 4, c8 = (pc & 15) * 8;
                float qv[8]; unpack8(*(const LAS u32x4*)(qb + row * 136 + c8), qv);
                const float sc = rq[row] * eg[row];
                f32x4 o0, o1;
#pragma unroll
                for (int q = 0; q < 4; ++q) { o0[q] = qv[q] * sc; o1[q] = qv[4 + q] * sc; }
                *(u32x4*)(qblk + row * 128 + c8) = pack8(o0, o1);
            }
        }
        P2_BAR();
        LAS bf16_t* Thi = (LAS bf16_t*)(lds + 36864);
        {
            const int c = th >> 2, t4 = th & 3;
            float z[16];
#pragma unroll
            for (int q = 0; q < 16; ++q) z[q] = 0.f;
#pragma unroll
            for (int i = 0; i < 64; ++i) {
                float p = 0.f;
#pragma unroll
                for (int q4 = 0; q4 < (i + 15) / 16; ++q4) {
                    const f32x4 lv = *(const LAS f32x4*)(Lf + i * 64 + t4 * 16 + q4 * 4);
                    p += lv[0] * z[q4 * 4]; p += lv[1] * z[q4 * 4 + 1]; p += lv[2] * z[q4 * 4 + 2]; p += lv[3] * z[q4 * 4 + 3];
                }
                p += __builtin_bit_cast(float, __builtin_amdgcn_update_dpp(0, __builtin_bit_cast(int, p), 0xB1, 0xF, 0xF, true));
                p += __builtin_bit_cast(float, __builtin_amdgcn_update_dpp(0, __builtin_bit_cast(int, p), 0x4E, 0xF, 0xF, true));
                const float y = ((i == c) ? 1.f : 0.f) - p;
                const bool mine = t4 == (i & 3);
                z[i >> 2] = mine ? y : z[i >> 2];
                if (mine) Thi[i * 72 + c] = f2bf(y);
                if ((i & 3) == 3) __builtin_amdgcn_sched_barrier(0);
            }
        }
        P2_BAR();
        {
            LAS unsigned char* rT = lds;
#pragma unroll
            for (int e = 0; e < 8; ++e) { u32x4 o;
#pragma unroll
                for (int q = 0; q < 4; ++q) o[q] = cvt_pk_bf16(x[e * 8 + 2 * q], x[e * 8 + 2 * q + 1]);
                *(LAS u32x4*)(rT + th * 144 + e * 16) = o; }
        }
        P2_BAR();
        {
            LAS unsigned char* rT = lds;
            bf16_t* wblk = ws_ + (size_t)ch * 8192;
            bf16x8 th_[2];
#pragma unroll
            for (int ksx = 0; ksx < 2; ++ksx) th_[ksx] = *(const LAS bf16x8*)(Thi + (16 * wv4 + ln) * 72 + 32 * ksx + 8 * lq);
#pragma unroll
            for (int nt8 = 0; nt8 < 8; ++nt8) {
                f32x4 acc = (f32x4){0.f, 0.f, 0.f, 0.f};
#pragma unroll
                for (int ksx = 0; ksx < 2; ++ksx) {
                    const bf16x8 bv = *(const LAS bf16x8*)(rT + (128 + 16 * nt8 + ln) * 144 + (32 * ksx + 8 * lq) * 2);
                    acc = mfma16(th_[ksx], bv, acc);
                }
                u32x2 o; o[0] = cvt_pk_bf16(acc[0], acc[1]); o[1] = cvt_pk_bf16(acc[2], acc[3]);
                *(u32x2*)(vblk + (16 * nt8 + ln) * 64 + 16 * wv4 + 4 * lq) = o;
            }
#pragma unroll
            for (int mm = 0; mm < 2; ++mm) {
                const int mt = 2 * wv4 + mm;
                bf16x8 ak[2];
#pragma unroll
                for (int ksx = 0; ksx < 2; ++ksx) ak[ksx] = *(const LAS bf16x8*)(rT + (16 * mt + ln) * 144 + (32 * ksx + 8 * lq) * 2);
#pragma unroll
                for (int nt4 = 0; nt4 < 4; ++nt4) {
                    f32x4 acc = (f32x4){0.f, 0.f, 0.f, 0.f};
#pragma unroll
                    for (int ksx = 0; ksx < 2; ++ksx) {
                        const bf16x8 bh = *(const LAS bf16x8*)(Thi + (16 * nt4 + ln) * 72 + 32 * ksx + 8 * lq);
                        acc = mfma16(ak[ksx], bh, acc);
                    }
                    u32x2 o; o[0] = cvt_pk_bf16(acc[0], acc[1]); o[1] = cvt_pk_bf16(acc[2], acc[3]);
                    *(u32x2*)(wblk + (16 * nt4 + ln) * 128 + 16 * mt + 4 * lq) = o;
                }
            }
        }
        P2_BAR();
    }
}

#undef P2_BAR
__device__ __forceinline__ void scan_phase(const Params& P, int l, LAS unsigned char* lds) {
    constexpr int W_OFF = 0, QD_OFF = 17408, KT_OFF = 34816, AT_OFF = 53248, OP_BYTES = 62464, ST_OFF = 2 * OP_BYTES, VT_OFF = ST_OFF + 8704;
    const int tid = opaque_tid(), lane = tid & 63, wv = tid >> 6, m = wv & 3, nt = wv >> 2;
    const bf16_t* qs = slotp(P, 2); const bf16_t* ks = slotp(P, 3); bf16_t* vs = slotp(P, 4); const bf16_t* wsl = slotp(P, 1); const bf16_t* ats = slotp(P, 6);
    const float* gtot = (const float*)(P.ws + WS_GTOT);
    const int ln = lane & 15, lq = lane >> 4;
    const int cid = (int)*(volatile LAS unsigned*)(lds + LDS_ST + 8);
    const bool remap = gridDim.x == 256u;
    const int it0 = (cid & 7) * 32 + (cid >> 3);
    for (int itx = blockIdx.x; itx < 768; itx += gridDim.x) {
        const int it = (remap && itx < 256) ? it0 : itx;
        int b, h, part, nsteps, ch0; bool smp;
        if (it < 256) { const int bh = it >> 2; part = it & 3; b = bh >> 3; h = bh & 7; nsteps = 64; ch0 = (b * 64) * 8 + h; smp = false; }
        else { const int j = it - 256, bh = j >> 2; part = j & 3; b = bh >> 3; h = bh & 7; nsteps = 1; ch0 = (512 + b) * 8 + h; smp = true; }
        f32x4 accS[2];
        float* sout = P.out + (smp ? O_DELTAS + ((size_t)(l * 16 + b) * 8 + h) * 16384 : O_DELTAP + ((size_t)(l * 8 + b) * 8 + h) * 16384);
#pragma unroll
        for (int t = 0; t < 2; ++t)
#pragma unroll
            for (int rg = 0; rg < 4; ++rg) {
                const int dk = 16 * wv + lq * 4 + rg, dv = part * 32 + 16 * t + ln;
                accS[t][rg] = smp ? P.state_delta[((size_t)(l * 16 + b) * 8 + h) * 16384 + dk * 128 + dv] : 0.f;
            }
        auto write_st = [&]() __attribute__((always_inline)) {
#pragma unroll
            for (int t = 0; t < 2; ++t) { u32x2 o; o[0] = cvt_pk_bf16(accS[t][0], accS[t][1]); o[1] = cvt_pk_bf16(accS[t][2], accS[t][3]);
                *(LAS u32x2*)(lds + ST_OFF + (16 * t + ln) * 272 + (16 * wv + lq * 4) * 2) = o; }
        };
        u32x4 pw[2], pq[2], pk[2], pa;
        auto gload = [&](int ch) __attribute__((always_inline)) {
            const u32x4* gw = (const u32x4*)(wsl + (size_t)ch * 8192); const u32x4* gq = (const u32x4*)(qs + (size_t)ch * 8192); const u32x4* gk = (const u32x4*)(ks + (size_t)ch * 8192);
            const u32x4* ga = (const u32x4*)(ats + (size_t)ch * 4096);
#pragma unroll
            for (int e = 0; e < 2; ++e) { pw[e] = gw[tid + 512 * e]; pq[e] = gq[tid + 512 * e]; pk[e] = gk[tid + 512 * e]; }
            pa = ga[tid];
        };
        auto lstore = [&](int bo) __attribute__((always_inline)) {
#pragma unroll
            for (int e = 0; e < 2; ++e) { const int p = tid + 512 * e;
                *(LAS u32x4*)(lds + bo + W_OFF + (p >> 4) * 272 + (p & 15) * 16) = pw[e];
                *(LAS u32x4*)(lds + bo + QD_OFF + (p >> 4) * 272 + (p & 15) * 16) = pq[e];
                *(LAS u32x4*)(lds + bo + KT_OFF + (p >> 3) * 144 + (p & 7) * 16) = pk[e]; }
            *(LAS u32x4*)(lds + bo + AT_OFF + (tid >> 3) * 144 + (tid & 7) * 16) = pa;
        };
#define LBAR() asm volatile("s_waitcnt lgkmcnt(0)\n\ts_barrier" ::: "memory")
        gload(ch0);
        write_st();
        lstore(0);
        bf16_t* up = vs + (size_t)ch0 * 8192 + (size_t)(part * 32 + 16 * nt + ln) * 64 + 16 * m + lq * 4;
        u32x2 uv = *(const u32x2*)up;
        float gt = gtot[ch0];
        if (nsteps > 1) gload(ch0 + 8);
        LBAR();
        for (int n = 0; n < nsteps; ++n) {
            const int ch = ch0 + n * 8;
            const int bo = (n & 1) * OP_BYTES;
            u32x2 uvn = uv; float gtn = gt;
            if (n + 1 < nsteps) {
                lstore(bo ^ OP_BYTES);
                uvn = *(const u32x2*)(up + 8 * 8192); gtn = gtot[ch + 8];
                if (n + 2 < nsteps) gload(ch + 16);
            }
            f32x4 accV = (f32x4){0.f, 0.f, 0.f, 0.f}, accQ = (f32x4){0.f, 0.f, 0.f, 0.f};
#pragma unroll
            for (int ksx = 0; ksx < 4; ++ksx) {
                const int ko = (32 * ksx + lq * 8) * 2;
                const bf16x8 aw = *(const LAS bf16x8*)(lds + bo + W_OFF + (16 * m + ln) * 272 + ko);
                const bf16x8 aq = *(const LAS bf16x8*)(lds + bo + QD_OFF + (16 * m + ln) * 272 + ko);
                const bf16x8 bs = *(const LAS bf16x8*)(lds + ST_OFF + (16 * nt + ln) * 272 + ko);
                accV = mfma16(aw, bs, accV); accQ = mfma16(aq, bs, accQ);
            }
            {
                const float u0 = __uint_as_float(uv[0] << 16), u1 = __uint_as_float(uv[0] & 0xffff0000u), u2 = __uint_as_float(uv[1] << 16), u3 = __uint_as_float(uv[1] & 0xffff0000u);
                u32x2 o; o[0] = cvt_pk_bf16(u0 - accV[0], u1 - accV[1]); o[1] = cvt_pk_bf16(u2 - accV[2], u3 - accV[3]);
                *(LAS u32x2*)(lds + VT_OFF + (16 * nt + ln) * 144 + (16 * m + lq * 4) * 2) = o;
            }
            LBAR();
#pragma unroll
            for (int ksx = 0; ksx < 2; ++ksx) {
                const int ko = (32 * ksx + lq * 8) * 2;
                const bf16x8 aa = *(const LAS bf16x8*)(lds + bo + AT_OFF + (16 * m + ln) * 144 + ko);
                const bf16x8 bv = *(const LAS bf16x8*)(lds + VT_OFF + (16 * nt + ln) * 144 + ko);
                accQ = mfma16(aa, bv, accQ);
            }
            { u32x2 o; o[0] = cvt_pk_bf16(accQ[0], accQ[1]); o[1] = cvt_pk_bf16(accQ[2], accQ[3]); *(u32x2*)up = o; }
#pragma unroll
            for (int t = 0; t < 2; ++t) {
                accS[t] = accS[t] * gt;
#pragma unroll
                for (int ksx = 0; ksx < 2; ++ksx) {
                    const int ko = (32 * ksx + lq * 8) * 2;
                    const bf16x8 ak = *(const LAS bf16x8*)(lds + bo + KT_OFF + (16 * wv + ln) * 144 + ko);
                    const bf16x8 bv = *(const LAS bf16x8*)(lds + VT_OFF + (16 * t + ln) * 144 + ko);
                    accS[t] = mfma16(ak, bv, accS[t]);
                }
            }
            write_st();
            LBAR();
            uv = uvn; gt = gtn; up += 8 * 8192;
        }
#undef LBAR
        __syncthreads();
#pragma unroll
        for (int t = 0; t < 2; ++t)
#pragma unroll
            for (int rg = 0; rg < 4; ++rg) { const int dk = 16 * wv + lq * 4 + rg, dv = part * 32 + 16 * t + ln; sout[dk * 128 + dv] = accS[t][rg]; }
    }
}

__device__ __forceinline__ void merge_phase(const Params& P, int l, LAS unsigned char* lds) {
    const int tid = opaque_tid();
    const bf16_t* os = slotp(P, 4); const bf16_t* zs = slotp(P, 5); bf16_t* mg = slotp(P, 2);
    const bf16_t* ma = (const bf16_t*)P.out; const bf16_t* gb = ma + (size_t)R * 1024;
    const float* gain = P.o_gain + l * 128;
    const int j = tid >> 3, g8 = tid & 7;
    u32x4 pre[2];
    u32x4 zr[2], gr[2], mr[2], nzr[2], ngr[2], nmr[2]; f32x4 gn[4];
#pragma unroll
    for (int e = 0; e < 2; ++e) { gn[2 * e] = *(const f32x4*)(gain + g8 * 16 + e * 8); gn[2 * e + 1] = *(const f32x4*)(gain + g8 * 16 + e * 8 + 4); }
    auto item_off = [&](int c2) __attribute__((always_inline)) -> size_t {
        const bool sm = c2 >= 4096; const int ck = c2 >> 3, hh = c2 & 7;
        const int rr0 = sm ? RP + (ck - 512) * 32 : ck * 64, nv = sm ? 32 : 64;
        return (size_t)(rr0 + (j < nv ? j : 0)) * 1024 + hh * 128 + g8 * 16;
    };
    if ((int)blockIdx.x < NCHH) { const u32x4* src = (const u32x4*)(os + (size_t)blockIdx.x * 8192); pre[0] = src[tid]; pre[1] = src[tid + 512];
        const size_t o0 = item_off(blockIdx.x);
#pragma unroll
        for (int e = 0; e < 2; ++e) { zr[e] = *(const u32x4*)(zs + o0 + e * 8); gr[e] = *(const u32x4*)(gb + o0 + e * 8); mr[e] = *(const u32x4*)(ma + o0 + e * 8); } }
    for (int ch = blockIdx.x; ch < NCHH; ch += gridDim.x) {
        const bool smp = ch >= 4096; const int chunk = ch >> 3, h = ch & 7;
        const int r0 = smp ? RP + (chunk - 512) * 32 : chunk * 64, nvalid = smp ? 32 : 64;
#pragma unroll
        for (int e = 0; e < 2; ++e) { const int p = tid + 512 * e; const int dvr = p >> 3; *(LAS u32x4*)(lds + ((dvr & 15) * 8 + (dvr >> 4)) * 144 + (p & 7) * 16) = pre[e]; }
        if (ch + (int)gridDim.x < NCHH) {
            const int c2 = ch + gridDim.x;
            const u32x4* src = (const u32x4*)(os + (size_t)c2 * 8192); pre[0] = src[tid]; pre[1] = src[tid + 512];
            const size_t o2 = item_off(c2);
#pragma unroll
            for (int e = 0; e < 2; ++e) { nzr[e] = *(const u32x4*)(zs + o2 + e * 8); ngr[e] = *(const u32x4*)(gb + o2 + e * 8); nmr[e] = *(const u32x4*)(ma + o2 + e * 8); }
        }
        const size_t off = (size_t)(r0 + (j < nvalid ? j : 0)) * 1024 + h * 128 + g8 * 16;
        __syncthreads();
        float o[16]; float ss = 0.f;
#pragma unroll
        for (int d = 0; d < 16; ++d) { o[d] = bf2f(*(const LAS bf16_t*)(lds + (d * 8 + g8) * 144 + j * 2)); ss += o[d] * o[d]; }
        ss += __shfl_xor(ss, 1); ss += __shfl_xor(ss, 2); ss += __shfl_xor(ss, 4);
        const float rn = rsqrtf(ss * (1.f / 128.f) + 1e-6f);
        if (j < nvalid) {
#pragma unroll
            for (int e = 0; e < 2; ++e) {
                float zv[8], gv[8], mv[8];
                unpack8(zr[e], zv); unpack8(gr[e], gv); unpack8(mr[e], mv);
                const f32x4 g0 = gn[2 * e], g1 = gn[2 * e + 1];
                f32x4 r0v, r1v;
#pragma unroll
                for (int q = 0; q < 4; ++q) {
                    r0v[q] = mv[q] + sigm(gv[q]) * (o[e * 8 + q] * rn * g0[q] * silu(zv[q]));
                    r1v[q] = mv[4 + q] + sigm(gv[4 + q]) * (o[e * 8 + 4 + q] * rn * g1[q] * silu(zv[4 + q]));
                }
                *(u32x4*)(mg + off + e * 8) = pack8(r0v, r1v);
            }
        }
#pragma unroll
        for (int e = 0; e < 2; ++e) { zr[e] = nzr[e]; gr[e] = ngr[e]; mr[e] = nmr[e]; }
        __syncthreads();
    }
}

#ifndef DBG_SLOTMASK
#define DBG_SLOTMASK 0
#endif
#ifndef DBG_RANGE
#define DBG_RANGE (RP * 1024)
#endif
template <int S> __device__ __forceinline__ void run_stage(const Params& P, int l, LAS unsigned char* lds) {
    bf16_t* wb = wbf(P);
    if constexpr (S == 11) {
        ln_phase(P, P.x_prompt, P.x_sample, P.ln_in_g, P.ln_in_b, slotp(P, 0), nullptr, 0, lds);
        __syncthreads();
        convert_weights(P, 0, lds);
    } else if constexpr (S == 12) {
        const size_t n = O_DELTAS + 2ull * 16 * 8 * 16384;
        const float* ab = (const float*)(P.ws + WS_AB);
        constexpr int SM = DBG_SLOTMASK;
        for (size_t i = (size_t)blockIdx.x * 512 + opaque_tid(); i < n; i += (size_t)gridDim.x * 512) {
            float v = 0.f;
            if ((SM & 256) && i < (size_t)R * 1024) { v = P.out[i]; if (!(fabsf(v) < 1e30f)) v = 777.f; }
            if ((SM & 1024) && i >= (size_t)R * 1024) { v = P.out[i]; if (!(fabsf(v) < 1e30f)) v = 777.f; }
            const size_t si = i % ((size_t)DBG_RANGE);
#pragma unroll
            for (int q = 0; q < 7; ++q) if ((SM >> q) & 1) { float w = bf2f(slotp(P, q)[si]); if (!(fabsf(w) < 1e30f)) w = 777.f; v += w * (float)(q + 1); }
            if (SM & 128) { float w = bf2f(wbf(P)[i % WB_E]); if (!(fabsf(w) < 1e30f)) w = 777.f; v += w; }
            if ((SM & 512) && i < (size_t)R * 16) { float w = ab[i]; if (!(fabsf(w) < 1e30f)) w = 777.f; v += w; }
            P.out[i] = v;
        }
    } else if constexpr (S == 13) {
        const size_t n = O_DELTAS + 2ull * 16 * 8 * 16384;
        for (size_t i = (size_t)blockIdx.x * 512 + opaque_tid(); i < n; i += (size_t)gridDim.x * 512) { const float v = P.out[i]; if (!(fabsf(v) < 1e30f)) P.out[i] = 777.f; }
    } else if constexpr (S == 0) { EpiIn E; E.up = slotp(P, 1); E.q = slotp(P, 2); E.z = slotp(P, 5); E.ga = (bf16_t*)P.out; E.halo = (bf16_t*)(P.ws + WS_HALO);
        E.pool_p = P.out + O_POOLP + (size_t)l * 8 * 15 * 1024; E.conv_p = P.out + O_CONVP + (size_t)l * 8 * 3 * 3072;
        E.pool_s = P.out + O_POOLS + (size_t)l * 16 * 15 * 1024; E.conv_s = P.out + O_CONVS + (size_t)l * 16 * 3 * 3072;
        run_gemm(lds, slotp(P, 0), 1024, 0, wb + WIN_E, R, 7168, 1024, E);
    } else if constexpr (S == 1) { mixed_phase(P, l);
    } else if constexpr (S == 2) { EpiPool E; E.ga = (bf16_t*)P.out; E.scale = P.pool_scale + l * 1024; run_gemm(lds, slotp(P, 6), 1024, 256, wb + WPOOL_E, R, 1024, 256, E);
    } else if constexpr (S == 3) { delta_pre_phase(P, l, lds);
    } else if constexpr (S == 4) { scan_phase(P, l, lds);
    } else if constexpr (S == 5) { merge_phase(P, l, lds);
    } else if constexpr (S == 6) { EpiRes E; E.res = slotp(P, 0); E.bias = nullptr; E.out = slotp(P, 5); E.part = (float*)(P.ws + WS_PART);
        run_gemm(lds, slotp(P, 2), 1024, 0, wb + WOUT_E, RP, 1024, 1024, E);
        E.res += (size_t)RP * 1024; E.out += (size_t)RP * 1024;
        run_gemm(lds, slotp(P, 2) + (size_t)RP * 1024, 1024, 0, wb + WOUT_E, RS, 1024, 1024, E, 4);
    } else if constexpr (S == 7) { ln_phase(P, nullptr, nullptr, P.ln1_g + l * 1024, P.ln1_b + l * 1024, slotp(P, 0), nullptr, -1, lds, (const float*)(P.ws + WS_PART), slotp(P, 5));
    } else if constexpr (S == 8) { EpiFF1 E; E.h = slotp(P, 1); E.bias = P.b_ff1 + l * 4096; run_gemm(lds, slotp(P, 0), 1024, 0, wb + WFF1_E, R, 4096, 1024, E);
    } else if constexpr (S == 9) { EpiRes E; E.res = slotp(P, 0); E.bias = P.b_ff2 + l * 1024; E.out = slotp(P, 5); E.part = (float*)(P.ws + WS_PART);
        run_gemm(lds, slotp(P, 1), 4096, 0, wb + WFF2_E, RP, 1024, 4096, E);
        E.res += (size_t)RP * 1024; E.out += (size_t)RP * 1024;
        run_gemm(lds, slotp(P, 1) + (size_t)RP * 4096, 4096, 0, wb + WFF2_E, RS, 1024, 4096, E, 4);
    } else {
        if (l == 0) { ln_phase(P, nullptr, nullptr, P.ln2_g, P.ln2_b, slotp(P, 0), nullptr, 1, lds, (const float*)(P.ws + WS_PART), slotp(P, 5)); __syncthreads(); convert_weights(P, 1, lds); }
        else ln_phase(P, nullptr, nullptr, P.ln2_g + 1024, P.ln2_b + 1024, nullptr, P.out, -1, lds, (const float*)(P.ws + WS_PART), slotp(P, 5));
    }
}
constexpr int NPHASES = 23;
__device__ __forceinline__ void run_phase(const Params& P, int ph, LAS unsigned char* lds) {
    if (ph == 0) { run_stage<11>(P, 0, lds); return; }
    const int l = (ph - 1) / 11, s = (ph - 1) % 11;
    switch (s) {
    case 0: run_stage<0>(P, l, lds); break;
    case 1: run_stage<1>(P, l, lds); break;
    case 2: run_stage<2>(P, l, lds); break;
    case 3: run_stage<3>(P, l, lds); break;
    case 4: run_stage<4>(P, l, lds); break;
    case 5: run_stage<5>(P, l, lds); break;
    case 6: run_stage<6>(P, l, lds); break;
    case 7: run_stage<7>(P, l, lds); break;
    case 8: run_stage<8>(P, l, lds); break;
    case 9: run_stage<9>(P, l, lds); break;
    default: run_stage<10>(P, l, lds); break;
    }
}

#if MK_SINGLE
__global__ void __launch_bounds__(512, 2) mega(Params P, int ph_lo, int ph_hi) {
    extern __shared__ __attribute__((aligned(16))) unsigned char shm[];
    LAS unsigned char* lds = (LAS unsigned char*)shm;
    cg::grid_group grid = cg::this_grid();
    volatile LAS unsigned* st = (volatile LAS unsigned*)(lds + LDS_ST);
    if (threadIdx.x == 0) { st[0] = 0u; st[1] = 0u; }
    __syncthreads();
    XcdBarrier xb; xb.bar = (unsigned*)(P.ws + WS_BAR); xb.x = xb_xcc_id(); xb.st = st;
    if (threadIdx.x == 0) {
        st[3] = xb_add(&xb.bar[XB_XCNT(xb.x)], 1u);
        st[2] = blockIdx.x;
    }
    __syncthreads();
    for (int ph = ph_lo; ph < ph_hi; ++ph) {
        if (ph_hi < 0) grid.sync();
        if (ph > ph_lo) xcd_barrier(xb);
        if (ph == ph_lo + 1) {
            if (threadIdx.x == 0) {
                bool ok = gridDim.x == 256u && xb.x < 8u;
                for (unsigned j = 0; j < 16; ++j) ok = ok && (xb_ld(&xb.bar[XB_XCNT(j)]) == (j < 8u ? 32u : 0u));
                if (ok) st[2] = xb.x + 8u * st[3];
            }
            __syncthreads();
        }
        run_phase(P, ph, lds);
    }
}
#else
template <int S> __global__ void __launch_bounds__(512, 2) stage_kernel(Params P, int l) {
    extern __shared__ __attribute__((aligned(16))) unsigned char shm[];
    if (threadIdx.x == 0) *(volatile LAS unsigned*)((LAS unsigned char*)shm + LDS_ST + 8) = blockIdx.x;
    __syncthreads();
    run_stage<S>(P, l, (LAS unsigned char*)shm);
}
template <int S> static void launch_stage(const Params& p, int l, int grid, hipStream_t stream) {
    static bool attr = false;
    if (!attr) { (void)hipFuncSetAttribute((const void*)stage_kernel<S>, hipFuncAttributeMaxDynamicSharedMemorySize, LDS_BYTES); attr = true; }
    hipLaunchKernelGGL(stage_kernel<S>, dim3(grid), dim3(512), LDS_BYTES, stream, p, l);
}
static void launch_phase(const Params& p, int ph, int grid, hipStream_t stream) {
    if (ph == 0) { launch_stage<11>(p, 0, grid, stream); return; }
    const int l = (ph - 1) / 11, s = (ph - 1) % 11;
    switch (s) {
    case 0: launch_stage<0>(p, l, grid, stream); break;
    case 1: launch_stage<1>(p, l, grid, stream); break;
    case 2: launch_stage<2>(p, l, grid, stream); break;
    case 3: launch_stage<3>(p, l, grid, stream); break;
    case 4: launch_stage<4>(p, l, grid, stream); break;
    case 5: launch_stage<5>(p, l, grid, stream); break;
    case 6: launch_stage<6>(p, l, grid, stream); break;
    case 7: launch_stage<7>(p, l, grid, stream); break;
    case 8: launch_stage<8>(p, l, grid, stream); break;
    case 9: launch_stage<9>(p, l, grid, stream); break;
    default: launch_stage<10>(p, l, grid, stream); break;
    }
}
#endif

extern "C" void kernel_launch(void* const* d_in, const int* in_sizes, int n_in, void* d_out, int out_size, void* d_ws, size_t ws_size, hipStream_t stream) {
    static int grid = 0;
    if (grid == 0) {
        if (n_in != 23 || ws_size < WS_END) { fprintf(stderr, "kernel_launch: unexpected n_in %d or ws_size %zu (< %zu)\n", n_in, ws_size, (size_t)WS_END); grid = -1; return; }
        int dev = 0, cus = 0;
        (void)hipGetDevice(&dev);
        (void)hipDeviceGetAttribute(&cus, hipDeviceAttributeMultiprocessorCount, dev);
#if MK_SINGLE
        int per_cu = 0;
        if (hipFuncSetAttribute((const void*)mega, hipFuncAttributeMaxDynamicSharedMemorySize, LDS_BYTES) != hipSuccess) { fprintf(stderr, "kernel_launch: hipFuncSetAttribute failed\n"); grid = -1; return; }
        if (hipOccupancyMaxActiveBlocksPerMultiprocessor(&per_cu, (const void*)mega, 512, LDS_BYTES) != hipSuccess || per_cu < 1) per_cu = 1;
        (void)hipGetLastError();
        grid = cus * per_cu;
#else
        grid = cus;
#endif
        if (grid > 256) grid = 256;
    }
    if (grid < 0) return;
    Params p{};
    const float** pp = (const float**)&p;
    for (int i = 0; i < 23; ++i) pp[i] = (const float*)d_in[i];
    p.out = (float*)d_out; p.ws = (unsigned char*)d_ws;
#if MK_SINGLE
    int lo = 0, hi = NPHASES;
    (void)hipMemsetAsync((unsigned char*)d_ws + WS_BAR, 0, 3456 * 4, stream);
    void* args[] = {&p, &lo, &hi};
    hipError_t e = hipLaunchCooperativeKernel((const void*)mega, dim3(grid), dim3(512), args, LDS_BYTES, stream);
    if (e != hipSuccess) fprintf(stderr, "cooperative launch failed: %s (grid %d)\n", hipGetErrorString(e), grid);
#else
#ifdef DBG_NPH
    for (int ph = 0; ph < DBG_NPH; ++ph) launch_phase(p, ph, grid, stream);
    launch_stage<12>(p, 0, grid, stream);
#else
    for (int ph = 0; ph < NPHASES; ++ph) {
#ifdef DUP_GROUP_END
        if (ph > 0 && (ph - 1) % 11 == 0) for (int q = 0; q <= DUP_GROUP_END; ++q) launch_phase(p, ph + q, grid, stream);
#endif
        launch_phase(p, ph, grid, stream);
#ifdef DUP_MASK
        if (ph > 0 && ((DUP_MASK >> ((ph - 1) % 11)) & 1)) launch_phase(p, ph, grid, stream);
#endif
    }
#endif
#endif
}
```

```cpp
#include <hip/hip_runtime.h>
#include <hip/hip_cooperative_groups.h>
#include <cstdio>
namespace cg = cooperative_groups;

#ifndef MK_SINGLE
#define MK_SINGLE 1
#endif

#define LAS __attribute__((address_space(3)))
#define GAS __attribute__((address_space(1)))
typedef unsigned short bf16_t;
typedef short bf16x8 __attribute__((ext_vector_type(8)));
typedef float f32x4 __attribute__((ext_vector_type(4)));
typedef unsigned u32x4 __attribute__((ext_vector_type(4)));
typedef unsigned u32x2 __attribute__((ext_vector_type(2)));

constexpr int DM = 1024, SEQ = 4096, RP = 8 * SEQ, RS = 16 * 32, R = RP + RS;
constexpr int INW = 7184, DFF = 4096;
constexpr int NCHH = (512 + 16) * 8;
constexpr size_t SLOT = (size_t)NCHH * 8192;
constexpr float ALPHA = 1.41421356237f;
constexpr size_t WIN_E = 0, WPOOL_E = 7168ull * 1024, WOUT_E = WPOOL_E + 1024ull * 256, WFF1_E = WOUT_E + 1024ull * 1024, WFF2_E = WFF1_E + 4096ull * 1024, WB_E = WFF2_E + 4096ull * 1024;
constexpr size_t WS_SLOT0 = WB_E * 2;
constexpr size_t WS_HALO = WS_SLOT0 + 7 * SLOT * 2;
constexpr size_t WS_AB = WS_HALO + 512ull * 3 * 3072 * 2;
constexpr size_t WS_GTOT = WS_AB + (size_t)R * 16 * 4;
constexpr size_t WS_BAR = WS_GTOT + (size_t)NCHH * 4;
constexpr size_t WS_PART = WS_BAR + 3456 * 4;
constexpr size_t WS_END = WS_PART + 3ull * RS * 1024 * 4;
constexpr size_t O_POOLP = (size_t)R * 1024, O_CONVP = O_POOLP + 2ull * 8 * 15 * 1024, O_DELTAP = O_CONVP + 2ull * 8 * 3 * 3072,
                 O_POOLS = O_DELTAP + 2ull * 8 * 8 * 16384, O_CONVS = O_POOLS + 2ull * 16 * 15 * 1024, O_DELTAS = O_CONVS + 2ull * 16 * 3 * 3072;
constexpr int LDS_ST = 139264;
constexpr int LDS_BYTES = LDS_ST + 16;

struct Params {
    const float *x_prompt, *x_sample, *state_pool, *state_conv, *state_delta, *ln_in_g, *ln_in_b, *w_in, *conv_w, *a_log, *dt_bias, *o_gain, *w_pool, *pool_scale,
        *w_out, *ln1_g, *ln1_b, *w_ff1, *b_ff1, *w_ff2, *b_ff2, *ln2_g, *ln2_b;
    float* out;
    unsigned char* ws;
};

__device__ __forceinline__ int opaque_tid() { int t = threadIdx.x; asm volatile("" : "+v"(t)); return t; }
__device__ __forceinline__ float bf2f(bf16_t b) { return __uint_as_float(((unsigned)b) << 16); }
__device__ __forceinline__ bf16_t f2bf(float f) { const __bf16 b = (__bf16)f; return __builtin_bit_cast(unsigned short, b); }
typedef float f32x2_t __attribute__((ext_vector_type(2)));
typedef __bf16 bf16x2_t __attribute__((ext_vector_type(2)));
__device__ __forceinline__ unsigned cvt_pk_bf16(float lo, float hi) { const f32x2_t v = {lo, hi}; const bf16x2_t b = __builtin_convertvector(v, bf16x2_t); return __builtin_bit_cast(unsigned, b); }
__device__ __forceinline__ u32x4 pack8(f32x4 a, f32x4 b) { u32x4 o; o[0] = cvt_pk_bf16(a[0], a[1]); o[1] = cvt_pk_bf16(a[2], a[3]); o[2] = cvt_pk_bf16(b[0], b[1]); o[3] = cvt_pk_bf16(b[2], b[3]); return o; }
__device__ __forceinline__ void unpack8(u32x4 v, float (&o)[8]) {
#pragma unroll
    for (int i = 0; i < 4; ++i) { o[2 * i] = __uint_as_float(v[i] << 16); o[2 * i + 1] = __uint_as_float(v[i] & 0xffff0000u); }
}
__device__ __forceinline__ float sigm(float x) { return __builtin_amdgcn_rcpf(1.f + __expf(-x)); }
__device__ __forceinline__ float silu(float x) { return x * __builtin_amdgcn_rcpf(1.f + __expf(-x)); }
__device__ __forceinline__ float softplus(float x) { const float e = __expf(-fabsf(x)); const float lp = (e < 1e-3f) ? e * (1.f - 0.5f * e) : __logf(1.f + e); return fmaxf(x, 0.f) + lp; }
__device__ __forceinline__ float wave_sum(float v) {
#pragma unroll
    for (int o = 1; o < 64; o <<= 1) v += __shfl_xor(v, o);
    return v;
}
__device__ __forceinline__ f32x4 mfma16(bf16x8 a, bf16x8 b, f32x4 c) { return __builtin_amdgcn_mfma_f32_16x16x32_bf16(a, b, c, 0, 0, 0); }
__device__ __forceinline__ bf16_t* slotp(const Params& P, int i) { return (bf16_t*)(P.ws + WS_SLOT0) + (size_t)i * SLOT; }
__device__ __forceinline__ bf16_t* wbf(const Params& P) { return (bf16_t*)P.ws; }


#define XB_TMO      128
#define XB_XCNT(j)  (256  + 64 * (j))
#define XB_XSUB(j)  (1280 + 64 * (j))
#define XB_XGEN(j)  (2304 + 64 * (j))
#define XB_TOP      3328
#define XB_TOPGEN   3392
#define XCD_BAR_WORDS 3456
#define XB_SPIN_CAP (1u << 18)
__device__ __forceinline__ unsigned xb_ld(unsigned* p)              { return __hip_atomic_load(p, __ATOMIC_RELAXED, __HIP_MEMORY_SCOPE_AGENT); }
__device__ __forceinline__ unsigned xb_add(unsigned* p, unsigned v) { return __hip_atomic_fetch_add(p, v, __ATOMIC_RELAXED, __HIP_MEMORY_SCOPE_AGENT); }
__device__ __forceinline__ unsigned xb_xcc_id() { return (unsigned)__builtin_amdgcn_s_getreg((3 << 11) | 20) & 0xFu; }
#define XB_SPIN(cond, bar) do { unsigned _sp = 0; while (cond) { __builtin_amdgcn_s_sleep(1); \
    if ((++_sp & 255u) == 0u) { if (xb_ld(&(bar)[XB_TMO])) break; if (_sp > XB_SPIN_CAP) { atomicAdd(&(bar)[XB_TMO], 1u); break; } } } } while (0)
struct XcdBarrier { unsigned* bar; unsigned x; volatile LAS unsigned* st; };
__device__ __forceinline__ XcdBarrier xcd_barrier_post(unsigned* bar, volatile LAS unsigned* st) {
    XcdBarrier b; b.bar = bar; b.x = xb_xcc_id(); b.st = st;
    if (threadIdx.x == 0) (void)xb_add(&bar[XB_XCNT(b.x)], 1u);
    return b;
}
__device__ __forceinline__ void xcd_barrier_complete(unsigned* bar, unsigned x, unsigned& nloc, unsigned& nx) {
    const unsigned G = gridDim.x * gridDim.y * gridDim.z;
    unsigned sum, cnt, mine, sp = 0u;
    for (;;) {
        sum = 0u; cnt = 0u; mine = 0u;
#pragma unroll
        for (unsigned j = 0; j < 16; ++j) { const unsigned c = xb_ld(&bar[XB_XCNT(j)]); sum += c; cnt += (c > 0u) ? 1u : 0u; mine = (j == x) ? c : mine; }
        if (sum == G) break;
        __builtin_amdgcn_s_sleep(1);
        if ((++sp & 255u) == 0u) { if (xb_ld(&bar[XB_TMO])) break; if (sp > XB_SPIN_CAP) { atomicAdd(&bar[XB_TMO], 1u); break; } }
    }
    nloc = mine > 0u ? mine : 1u; nx = cnt > 0u ? cnt : 1u;
}
__device__ __forceinline__ void xcd_barrier(const XcdBarrier& b) {
    asm volatile("s_waitcnt vmcnt(0)" ::: "memory");
    __syncthreads();
    if (threadIdx.x == 0) {
        unsigned* bar = b.bar;
        __builtin_amdgcn_s_waitcnt(0);
        unsigned nloc = b.st[0], nx = b.st[1];
        if (nloc == 0u) { xcd_barrier_complete(bar, b.x, nloc, nx); b.st[0] = nloc; b.st[1] = nx; }
        const unsigned old = xb_add(&bar[XB_XSUB(b.x)], 1u);
        const unsigned gen = old / nloc;
        if (old + 1u == (gen + 1u) * nloc) {
            __builtin_amdgcn_fence(__ATOMIC_RELEASE, "agent");
            asm volatile("s_waitcnt vmcnt(0)" ::: "memory");
            const unsigned og = xb_add(&bar[XB_TOP], 1u);
            const unsigned tg = og / nx;
            if (og + 1u == (tg + 1u) * nx) xb_add(&bar[XB_TOPGEN], 1u);
            else XB_SPIN(xb_ld(&bar[XB_TOPGEN]) == tg, bar);
            __builtin_amdgcn_fence(__ATOMIC_ACQUIRE, "agent");
            xb_add(&bar[XB_XGEN(b.x)], 1u);
            asm volatile("s_waitcnt vmcnt(0)" ::: "memory");
        } else {
            XB_SPIN(xb_ld(&bar[XB_XGEN(b.x)]) == gen, bar);
            __builtin_amdgcn_fence(__ATOMIC_ACQUIRE, "agent");
            asm volatile("s_waitcnt vmcnt(0)" ::: "memory");
        }
    }
    __syncthreads();
}

namespace pg8 {
constexpr int BM = 256, BK = 64, HALF = 128, HTB = HALF * BK * 2, NXCD = 8, WGM = 8;
__device__ __forceinline__ int lds_byte(int r, int c) { const int st = (r >> 4) * 2 + (c >> 5), rr = r & 15, cc = c & 31, ob = rr * 64 + cc * 2; return st * 1024 + (ob ^ (((ob >> 9) & 1) << 5)); }
__device__ __forceinline__ void stage_rc(int b, int& Rr, int& C) { const int st = b / 1024, sb = b % 1024, swz = sb ^ (((sb >> 9) & 1) << 5); Rr = (st >> 1) * 16 + swz / 64; C = (st & 1) * 32 + (swz % 64) / 2; }
__device__ __forceinline__ int perm32(int rho) { const int n = rho >> 4, i = rho & 15; return 8 * (i >> 2) + 4 * n + (i & 3); }
struct Unit { int pm, pn, ks; };
struct Gemm { const bf16_t* A; const bf16_t* Bt; int M, N, K, lda, apn, ldb, nks; };
struct StaticOrder {
    int nM, nN, nwg, G, c;
    int nNr;
    __device__ void init(int M, int N, int nks, int G_, int c_) { nM = M / BM; nNr = N / BM; nN = nNr * nks; nwg = nM * nN; G = G_; c = c_; }
    __device__ bool next(int i, Unit& u) const {
        const long L = (long)i * G + c; if (L >= nwg) return false;
        int wgid = (int)L; { const int q = nwg / NXCD, r = nwg % NXCD, xcd = wgid % NXCD, off = wgid / NXCD; wgid = (xcd < r ? xcd * (q + 1) : r * (q + 1) + (xcd - r) * q) + off; }
        const int nig = WGM * nN, gid = wgid / nig, fm = gid * WGM, gsz = (nM - fm) < WGM ? (nM - fm) : WGM;
        u.pm = fm + ((wgid % nig) % gsz); const int pq = (wgid % nig) / gsz; u.pn = pq % nNr; u.ks = pq / nNr; return true;
    }
};
template <class Epi>
__device__ __forceinline__ void gemm_phase(LAS unsigned char* lds, const Gemm g, const StaticOrder& S, const Epi& E) {
    const int tid = opaque_tid(), wid = __builtin_amdgcn_readfirstlane(tid >> 6), lane = tid & 63, wr = wid >> 2, wc = wid & 3, fr = lane & 15, fq = lane >> 4;
    int K_ = g.K; asm volatile("" : "+s"(K_));
    const int K = K_, nt = K / BK, lda = g.lda;
    unsigned voffA[2], voffB[2];
#pragma unroll
    for (int i = 0; i < 2; ++i) { int Rr, C; stage_rc(tid * 16 + i * 8192, Rr, C); const int Rb = Epi::PERM ? ((Rr & ~31) + perm32(Rr & 31)) : Rr;
        voffA[i] = (unsigned)(Rr * lda + C) * 2u; voffB[i] = (unsigned)(Rb * g.ldb + C) * 2u; }
    const size_t kstep = (size_t)(BK * 2);
    const size_t hstepA = (size_t)HALF * lda * 2, hstepB = (size_t)HALF * g.ldb * 2, sstep = (size_t)K * 2;
    const size_t tstepA = 2 * hstepA, tstepB = 2 * hstepB;
    const unsigned ldsw = (unsigned)wid * 1024u;
    const int aoff = lds_byte(wr * 64 + fr, fq * 8), boff = lds_byte(wc * 32 + fr, fq * 8);
#define PG8_SA(b, h) (((b) * 2 + (h)) * HTB)
#define PG8_SB(b, h) ((4 + (b) * 2 + (h)) * HTB)
#define PG8_STAGE(bufoff, gbase, voff) do { _Pragma("unroll") for (int _i = 0; _i < 2; ++_i) \
        __builtin_amdgcn_global_load_lds((const unsigned*)((const char*)(gbase) + (voff)[_i]), (LAS unsigned*)(lds + (bufoff) + ldsw + _i * 8192), 16, 0, 0); } while (0)
#define PG8_LDA(dst, b, h) do { _Pragma("unroll") for (int m = 0; m < 4; ++m) _Pragma("unroll") for (int k = 0; k < 2; ++k) dst[m][k] = *(const LAS bf16x8*)(lds + PG8_SA(b, h) + aoff + m * 2048 + k * 1024); } while (0)
#define PG8_LDB(dst, b, h) do { _Pragma("unroll") for (int n = 0; n < 2; ++n) _Pragma("unroll") for (int k = 0; k < 2; ++k) dst[n][k] = *(const LAS bf16x8*)(lds + PG8_SB(b, h) + boff + n * 2048 + k * 1024); } while (0)
#define PG8_MMA(ai, bj, At, Bt) do { __builtin_amdgcn_s_setprio(1); _Pragma("unroll") for (int m = 0; m < 4; ++m) _Pragma("unroll") for (int n = 0; n < 2; ++n) _Pragma("unroll") for (int k = 0; k < 2; ++k) \
        acc[ai][bj][m][n] = __builtin_amdgcn_mfma_f32_16x16x32_bf16(Bt[n][k], At[m][k], acc[ai][bj][m][n], 0, 0, 0); __builtin_amdgcn_s_setprio(0); } while (0)
#define PG8_WAIT_V(n) asm volatile("s_waitcnt vmcnt(" #n ")" ::: "memory")
#define PG8_WAIT_L(n) asm volatile("s_waitcnt lgkmcnt(" #n ")" ::: "memory")
#define PG8_BAR __builtin_amdgcn_s_barrier()
#define PG8_SCHED __builtin_amdgcn_sched_barrier(0)
    Unit cur, nxt; int ui = 0;
    if (!S.next(0, cur)) return;
    f32x4 acc[2][2][4][2];
#pragma unroll
    for (int a = 0; a < 2; ++a)
#pragma unroll
        for (int b = 0; b < 2; ++b)
#pragma unroll
            for (int m = 0; m < 4; ++m)
#pragma unroll
                for (int n = 0; n < 2; ++n) acc[a][b][m][n] = (f32x4){0.f, 0.f, 0.f, 0.f};
    bf16x8 At[4][2], B0[2][2], B1[2][2];
    const char* cA = (const char*)g.A + (size_t)cur.pm * tstepA + (size_t)cur.pn * g.apn * 2 + (size_t)cur.ks * sstep; const char* cB = (const char*)g.Bt + (size_t)cur.pn * tstepB + (size_t)cur.ks * sstep;
    PG8_STAGE(PG8_SB(0, 0), cB, voffB); PG8_STAGE(PG8_SB(0, 1), cB + hstepB, voffB); PG8_STAGE(PG8_SA(0, 0), cA, voffA); PG8_STAGE(PG8_SA(0, 1), cA + hstepA, voffA);
    if (wr == 1) PG8_BAR;
    PG8_WAIT_V(2); PG8_BAR;
    PG8_STAGE(PG8_SB(1, 0), cB + kstep, voffB); PG8_STAGE(PG8_SA(1, 0), cA + kstep, voffA); PG8_STAGE(PG8_SB(1, 1), cB + hstepB + kstep, voffB);
    PG8_WAIT_V(6); PG8_BAR;
    for (;;) {
        const bool has_next = S.next(ui + 1, nxt);
        const char* nA = has_next ? (const char*)g.A + (size_t)nxt.pm * tstepA + (size_t)nxt.pn * g.apn * 2 + (size_t)nxt.ks * sstep : cA; const char* nB = has_next ? (const char*)g.Bt + (size_t)nxt.pn * tstepB + (size_t)nxt.ks * sstep : cB;
        for (int t = 0; t < nt; t += 2) {
            const bool last = (t == nt - 2);
            const char* a1 = cA + (size_t)(t + 1) * kstep;
            const char* a2 = last ? nA : cA + (size_t)(t + 2) * kstep; const char* b2 = last ? nB : cB + (size_t)(t + 2) * kstep;
            const char* a3 = a2 + kstep; const char* b3 = b2 + kstep;
            PG8_LDB(B0, 0, 0); PG8_LDB(B1, 0, 1); PG8_SCHED; PG8_LDA(At, 0, 0); PG8_STAGE(PG8_SA(1, 1), a1 + hstepA, voffA);
            PG8_WAIT_V(8); PG8_WAIT_L(0); PG8_BAR; PG8_MMA(0, 0, At, B0); PG8_MMA(0, 1, At, B1); PG8_BAR; PG8_SCHED;
            PG8_LDA(At, 0, 1); PG8_STAGE(PG8_SB(0, 0), b2, voffB); PG8_STAGE(PG8_SB(0, 1), b2 + hstepB, voffB); PG8_STAGE(PG8_SA(0, 0), a2, voffA);
            PG8_WAIT_V(8); PG8_WAIT_L(0); PG8_BAR; PG8_MMA(1, 0, At, B0); PG8_MMA(1, 1, At, B1); PG8_BAR; PG8_SCHED;
            PG8_LDB(B0, 1, 0); PG8_LDB(B1, 1, 1); PG8_SCHED; PG8_LDA(At, 1, 0); PG8_STAGE(PG8_SA(0, 1), a2 + hstepA, voffA);
            PG8_WAIT_V(8); PG8_WAIT_L(0); PG8_BAR; PG8_MMA(0, 0, At, B0); PG8_MMA(0, 1, At, B1); PG8_BAR; PG8_SCHED;
            PG8_LDA(At, 1, 1); PG8_STAGE(PG8_SB(1, 0), b3, voffB); PG8_STAGE(PG8_SB(1, 1), b3 + hstepB, voffB); PG8_STAGE(PG8_SA(1, 0), a3, voffA);
            PG8_WAIT_V(8); PG8_WAIT_L(0); PG8_BAR; PG8_MMA(1, 0, At, B0); PG8_MMA(1, 1, At, B1); PG8_BAR; PG8_SCHED;
        }
        if (wr == 0) PG8_BAR;
        E(acc, cur, wr, wc, fr, fq);
        if (!has_next) break;
#pragma unroll
        for (int a = 0; a < 2; ++a)
#pragma unroll
            for (int b = 0; b < 2; ++b)
#pragma unroll
                for (int m = 0; m < 4; ++m)
#pragma unroll
                    for (int n = 0; n < 2; ++n) acc[a][b][m][n] = (f32x4){0.f, 0.f, 0.f, 0.f};
        cur = nxt; cA = nA; cB = nB; ++ui;
        if (wr == 1) PG8_BAR;
    }
    PG8_WAIT_V(0);
    PG8_BAR;
#undef PG8_SA
#undef PG8_SB
#undef PG8_STAGE
#undef PG8_LDA
#undef PG8_LDB
#undef PG8_MMA
#undef PG8_WAIT_V
#undef PG8_WAIT_L
#undef PG8_BAR
#undef PG8_SCHED
}
}
using pg8::Unit;
typedef f32x4 Acc[2][2][4][2];

struct EpiIn {
    static constexpr bool PERM = true;
    bf16_t *up, *q, *z, *ga; bf16_t* halo; float *pool_p, *conv_p, *pool_s, *conv_s;
    __device__ __forceinline__ void operator()(const Acc& acc, const Unit& u, int wr, int wc, int fr, int fq) const {
        const int t = u.pn >> 2;
        const int csb = (u.pn & 3) * 256 + wc * 32 + 8 * fq;
        const bool smp = u.pm >= 128;
        const bool lastp = !smp && (u.pm & 15) == 15;
#pragma unroll
        for (int ai = 0; ai < 2; ++ai)
#pragma unroll
            for (int m = 0; m < 4; ++m) {
                const int r = u.pm * 256 + ai * 128 + wr * 64 + m * 16 + fr;
                const int rs = r - RP;
#pragma unroll
                for (int bj = 0; bj < 2; ++bj) {
                    const int cs = csb + bj * 128;
                    const f32x4 v0 = acc[ai][bj][m][0], v1 = acc[ai][bj][m][1];
                    const u32x4 pk = pack8(v0, v1);
                    if (t == 0) {
                        *(u32x4*)(up + (size_t)r * 1024 + cs) = pk;
                        if (m == 3 && ai == 1 && lastp && wr == 1 && fr >= 1) {
                            float* so = pool_p + ((size_t)((r >> 12) * 15 + ((r & 4095) - 4081))) * 1024 + cs; *(f32x4*)so = v0; *(f32x4*)(so + 4) = v1; }
                        if ((m & 1) && smp && fr >= 1) {
                            float* so = pool_s + ((size_t)((rs >> 5) * 15 + ((rs & 31) - 17))) * 1024 + cs; *(f32x4*)so = v0; *(f32x4*)(so + 4) = v1; }
                    } else if (t <= 3) {
                        const int h = cs >> 7, c = cs & 127;
                        const size_t blk = smp ? ((size_t)((512 + (rs >> 5)) * 8 + h) * 64 + (rs & 31)) : ((size_t)((r >> 6) * 8 + h) * 64 + (r & 63));
                        *(u32x4*)(q + (size_t)(t - 1) * SLOT + blk * 128 + c) = pk;
                        const int cc = (t - 1) * 1024 + cs;
                        if (m == 3 && !smp && fr >= 13) {
                            const int chunk = r >> 6, i3 = (r & 63) - 61;
                            if ((chunk & 63) == 63) { float* so = conv_p + ((size_t)((r >> 12) * 3 + i3)) * 3072 + cc; *(f32x4*)so = v0; *(f32x4*)(so + 4) = v1; }
                            else *(u32x4*)(halo + ((size_t)(chunk + 1) * 3 + i3) * 3072 + cc) = pk;
                        }
                        if ((m & 1) && smp && fr >= 13) {
                            float* so = conv_s + ((size_t)((rs >> 5) * 3 + ((rs & 31) - 29))) * 3072 + cc; *(f32x4*)so = v0; *(f32x4*)(so + 4) = v1; }
                    } else if (t == 4) {
                        *(u32x4*)(z + (size_t)r * 1024 + cs) = pk;
                    } else {
                        *(u32x4*)(ga + (size_t)(t - 5) * R * 1024 + (size_t)r * 1024 + cs) = pk;
                    }
                }
            }
    }
};
struct EpiPool {
    static constexpr bool PERM = true;
    bf16_t* ga; const float* scale;
    __device__ __forceinline__ void operator()(const Acc& acc, const Unit& u, int wr, int wc, int fr, int fq) const {
        const int rb = u.pm * 256 + wr * 64 + fr, cb = u.pn * 256 + wc * 32 + 8 * fq;
        u32x4 gas[2][4];
        auto ldgrp = [&](int g, int slot) __attribute__((always_inline)) {
            const int c = cb + (g >> 1) * 128, ai = g & 1;
#pragma unroll
            for (int m = 0; m < 4; ++m) gas[slot][m] = *(const u32x4*)(ga + (size_t)(rb + ai * 128 + m * 16) * 1024 + c);
        };
        f32x4 sc[2][2];
#pragma unroll
        for (int bj = 0; bj < 2; ++bj) { sc[bj][0] = *(const f32x4*)(scale + cb + bj * 128); sc[bj][1] = *(const f32x4*)(scale + cb + bj * 128 + 4); }
        ldgrp(0, 0);
#pragma unroll
        for (int g = 0; g < 4; ++g) {
            const int slot = g & 1, bj = g >> 1, ai = g & 1;
            if (g + 1 < 4) ldgrp(g + 1, slot ^ 1);
            const int c = cb + bj * 128;
#pragma unroll
            for (int m = 0; m < 4; ++m) {
                float gv[8]; unpack8(gas[slot][m], gv);
                f32x4 v0 = acc[ai][bj][m][0], v1 = acc[ai][bj][m][1];
#pragma unroll
                for (int e = 0; e < 4; ++e) { v0[e] = sigm(gv[e]) * sc[bj][0][e] * v0[e]; v1[e] = sigm(gv[4 + e]) * sc[bj][1][e] * v1[e]; }
                *(u32x4*)(ga + (size_t)(rb + ai * 128 + m * 16) * 1024 + c) = pack8(v0, v1);
            }
        }
    }
};
struct EpiRes {
    static constexpr bool PERM = true;
    const bf16_t* res; const float* bias; bf16_t* out; float* part;
    __device__ __forceinline__ void operator()(const Acc& acc, const Unit& u, int wr, int wc, int fr, int fq) const {
        const int rb = u.pm * 256 + wr * 64 + fr, cb = u.pn * 256 + wc * 32 + 8 * fq;
        if (u.ks > 0) {
#pragma unroll
            for (int bj = 0; bj < 2; ++bj)
#pragma unroll
                for (int n = 0; n < 2; ++n)
#pragma unroll
                    for (int ai = 0; ai < 2; ++ai)
#pragma unroll
                        for (int m = 0; m < 4; ++m) *(f32x4*)(part + ((size_t)(u.ks - 1) * RS + rb + ai * 128 + m * 16) * 1024 + cb + bj * 128 + 4 * n) = acc[ai][bj][m][n];
            return;
        }
        u32x4 rv[2][4]; f32x4 bv[2][2];
#pragma unroll
        for (int bj = 0; bj < 2; ++bj)
#pragma unroll
            for (int n = 0; n < 2; ++n) bv[bj][n] = bias ? *(const f32x4*)(bias + cb + bj * 128 + 4 * n) : (f32x4){0.f, 0.f, 0.f, 0.f};
        auto ldgrp = [&](int g, int slot) __attribute__((always_inline)) {
            const int c = cb + (g >> 1) * 128, ai = g & 1;
#pragma unroll
            for (int m = 0; m < 4; ++m) rv[slot][m] = *(const u32x4*)(res + (size_t)(rb + ai * 128 + m * 16) * 1024 + c);
        };
        ldgrp(0, 0);
#pragma unroll
        for (int g = 0; g < 4; ++g) {
            const int slot = g & 1, bj = g >> 1, ai = g & 1;
            if (g + 1 < 4) ldgrp(g + 1, slot ^ 1);
            const int c = cb + bj * 128;
#pragma unroll
            for (int m = 0; m < 4; ++m) {
                float x[8]; unpack8(rv[slot][m], x);
                f32x4 o0 = acc[ai][bj][m][0] + bv[bj][0], o1 = acc[ai][bj][m][1] + bv[bj][1];
#pragma unroll
                for (int e = 0; e < 4; ++e) { o0[e] += ALPHA * x[e]; o1[e] += ALPHA * x[4 + e]; }
                *(u32x4*)(out + (size_t)(rb + ai * 128 + m * 16) * 1024 + c) = pack8(o0, o1);
            }
        }
    }
};
struct EpiFF1 {
    static constexpr bool PERM = true;
    bf16_t* h; const float* bias;
    __device__ __forceinline__ void operator()(const Acc& acc, const Unit& u, int wr, int wc, int fr, int fq) const {
        f32x4 bb[2][2];
#pragma unroll
        for (int bj = 0; bj < 2; ++bj) { const int c = u.pn * 256 + bj * 128 + wc * 32 + 8 * fq; bb[bj][0] = *(const f32x4*)(bias + c); bb[bj][1] = *(const f32x4*)(bias + c + 4); }
#pragma unroll
        for (int bj = 0; bj < 2; ++bj) {
            const int c = u.pn * 256 + bj * 128 + wc * 32 + 8 * fq;
            const f32x4 b0 = bb[bj][0], b1 = bb[bj][1];
#pragma unroll
            for (int ai = 0; ai < 2; ++ai)
#pragma unroll
                for (int m = 0; m < 4; ++m) {
                    const int r = u.pm * 256 + ai * 128 + wr * 64 + m * 16 + fr;
                    f32x4 v0 = acc[ai][bj][m][0] + b0, v1 = acc[ai][bj][m][1] + b1;
#pragma unroll
                    for (int e = 0; e < 4; ++e) { const float a = fmaxf(v0[e], 0.f), b = fmaxf(v1[e], 0.f); v0[e] = a * a; v1[e] = b * b; }
                    *(u32x4*)(h + (size_t)r * DFF + c) = pack8(v0, v1);
                }
        }
    }
};
template <class Epi> __device__ __forceinline__ void run_gemm(LAS unsigned char* lds, const bf16_t* A, int lda, int apn, const bf16_t* Bt, int M, int N, int K, const Epi& E, int nks = 1) {
    pg8::Gemm g; g.A = A; g.Bt = Bt; g.M = M; g.N = N; g.K = K / nks; g.lda = lda; g.apn = apn; g.ldb = K; g.nks = nks;
    pg8::StaticOrder S; S.init(M, N, nks, (int)gridDim.x, (int)*(volatile LAS unsigned*)(lds + LDS_ST + 8));
    pg8::gemm_phase<Epi>(lds, g, S, E);
}

struct TileRef { const float* src; bf16_t* dst; int ld_src, ld_dst; };
__device__ __forceinline__ TileRef weight_tile(const Params& P, int l, int it) {
    bf16_t* wb = wbf(P); TileRef t; int kb, nb;
    if (it < 1792) { kb = it / 112; nb = it % 112; t.src = P.w_in + (size_t)l * 1024 * INW; t.ld_src = INW; t.dst = wb + WIN_E; t.ld_dst = 1024; }
    else if (it < 1856) { const int j = it - 1792, g = j >> 4; kb = (j >> 2) & 3; nb = j & 3; t.src = P.w_pool + ((size_t)l * 4 + g) * 65536; t.ld_src = 256; t.dst = wb + WPOOL_E + (size_t)g * 65536; t.ld_dst = 256; }
    else if (it < 2112) { const int j = it - 1856; kb = j >> 4; nb = j & 15; t.src = P.w_out + (size_t)l * 1048576; t.ld_src = 1024; t.dst = wb + WOUT_E; t.ld_dst = 1024; }
    else if (it < 3136) { const int j = it - 2112; kb = j >> 6; nb = j & 63; t.src = P.w_ff1 + (size_t)l * 4194304; t.ld_src = 4096; t.dst = wb + WFF1_E; t.ld_dst = 1024; }
    else { const int j = it - 3136; kb = j >> 4; nb = j & 15; t.src = P.w_ff2 + (size_t)l * 4194304; t.ld_src = 1024; t.dst = wb + WFF2_E; t.ld_dst = 4096; }
    t.src += (size_t)(kb * 64) * t.ld_src + nb * 64; t.dst += (size_t)(nb * 64) * t.ld_dst + kb * 64;
    return t;
}
__device__ __forceinline__ void convert_weights(const Params& P, int l, LAS unsigned char* lds) {
    LAS float* t = (LAS float*)lds;
    const int tid = opaque_tid();
    const int kk0 = tid >> 4, n4 = (tid & 15) * 4, G = (int)gridDim.x;
    f32x4 preA[2], preB[2], preC[2];
    auto ldt = [&](int it, f32x4 (&pre)[2]) __attribute__((always_inline)) {
        if (it < 4160) { const TileRef T = weight_tile(P, l, it);
#pragma unroll
            for (int p = 0; p < 2; ++p) pre[p] = *(const f32x4*)(T.src + (size_t)(kk0 + 32 * p) * T.ld_src + n4); }
    };
    auto doit = [&](int it, const f32x4 (&pre)[2]) __attribute__((always_inline)) {
        const TileRef T = weight_tile(P, l, it);
#pragma unroll
        for (int p = 0; p < 2; ++p) { const int kk = kk0 + 32 * p; t[kk * 65 + n4] = pre[p][0]; t[kk * 65 + n4 + 1] = pre[p][1]; t[kk * 65 + n4 + 2] = pre[p][2]; t[kk * 65 + n4 + 3] = pre[p][3]; }
        __syncthreads();
        { const int n = tid >> 3, k8 = (tid & 7) * 8; u32x4 o;
#pragma unroll
          for (int e = 0; e < 4; ++e) o[e] = cvt_pk_bf16(t[(k8 + 2 * e) * 65 + n], t[(k8 + 2 * e + 1) * 65 + n]);
          *(u32x4*)(T.dst + (size_t)n * T.ld_dst + k8) = o; }
        __syncthreads();
    };
    int it = blockIdx.x;
    ldt(it, preA); ldt(it + G, preB); ldt(it + 2 * G, preC);
    while (it < 4160) {
        doit(it, preA); ldt(it + 3 * G, preA); it += G; if (it >= 4160) break;
        doit(it, preB); ldt(it + 3 * G, preB); it += G; if (it >= 4160) break;
        doit(it, preC); ldt(it + 3 * G, preC); it += G;
    }
}

template <int N> __device__ __forceinline__ float reduce_scatter(float (&v)[N], int lane);
__device__ __forceinline__ int bitrev(int x, int bits);
__device__ __forceinline__ void ln_phase(const Params& P, const float* src0, const float* src1, const float* g, const float* b, bf16_t* xb, float* yf, int wl, LAS unsigned char* lds, const float* part = nullptr, const bf16_t* srcb = nullptr) {
    LAS float* wt = (LAS float*)lds;
    const int tid = opaque_tid(), lane = tid & 63, wid = tid >> 6;
    if (wl >= 0) {
        const float* w16 = P.w_in + (size_t)wl * 1024 * INW + 7168;
        for (int i = tid; i < 1024 * 4; i += 512) { const int k = i >> 2, j4 = (i & 3) * 4; const f32x4 v = *(const f32x4*)(w16 + (size_t)k * INW + j4);
            const int kk = ((k >> 8) * 4 + (k & 3)) * 64 + ((k >> 2) & 63); *(LAS f32x4*)(wt + kk * 16 + j4) = v; }
        __syncthreads();
    }
    f32x4 gv[4], bv[4];
#pragma unroll
    for (int j = 0; j < 4; ++j) { gv[j] = *(const f32x4*)(g + lane * 4 + 256 * j); bv[j] = *(const f32x4*)(b + lane * 4 + 256 * j); }
    float* ab = (float*)(P.ws + WS_AB);
    const int rstride = gridDim.x * 8;
    f32x4 vn[4], vn2[4];
    auto ldrow = [&](int rr, f32x4 (&d)[4]) __attribute__((always_inline)) {
        if (rr < R) {
            if (srcb) {
#pragma unroll
                for (int j = 0; j < 4; ++j) { const u32x2 t = *(const u32x2*)(srcb + (size_t)rr * 1024 + lane * 4 + 256 * j);
                    d[j][0] = __uint_as_float(t[0] << 16); d[j][1] = __uint_as_float(t[0] & 0xffff0000u); d[j][2] = __uint_as_float(t[1] << 16); d[j][3] = __uint_as_float(t[1] & 0xffff0000u); }
            } else { const float* xr = (rr < RP) ? src0 + (size_t)rr * 1024 : src1 + (size_t)(rr - RP) * 1024;
#pragma unroll
                for (int j = 0; j < 4; ++j) d[j] = *(const f32x4*)(xr + lane * 4 + 256 * j); }
        }
    };
    ldrow(blockIdx.x * 8 + wid, vn); ldrow(blockIdx.x * 8 + wid + rstride, vn2);
    for (int r = blockIdx.x * 8 + wid; r < R; r += rstride) {
        f32x4 v[4]; float s = 0.f;
#pragma unroll
        for (int j = 0; j < 4; ++j) { v[j] = vn[j]; vn[j] = vn2[j]; }
        ldrow(r + 2 * rstride, vn2);
        if (part && r >= RP) {
#pragma unroll
            for (int q = 0; q < 3; ++q)
#pragma unroll
                for (int j = 0; j < 4; ++j) v[j] = v[j] + *(const f32x4*)(part + ((size_t)q * RS + (r - RP)) * 1024 + lane * 4 + 256 * j);
        }
        float s2 = 0.f;
#pragma unroll
        for (int j = 0; j < 4; ++j) { s += (v[j][0] + v[j][1]) + (v[j][2] + v[j][3]); s2 += (v[j][0] * v[j][0] + v[j][1] * v[j][1]) + (v[j][2] * v[j][2] + v[j][3] * v[j][3]); }
#pragma unroll
        for (int o = 1; o < 64; o <<= 1) { s += __shfl_xor(s, o); s2 += __shfl_xor(s2, o); }
        const float mean = s * (1.f / 1024.f);
        const float rstd = rsqrtf(fmaxf(s2 * (1.f / 1024.f) - mean * mean, 0.f) + 1e-5f);
#pragma unroll
        for (int j = 0; j < 4; ++j) v[j] = v[j] - mean;
#pragma unroll
        for (int j = 0; j < 4; ++j) v[j] = v[j] * rstd * gv[j] + bv[j];
        if (xb) {
#pragma unroll
            for (int j = 0; j < 4; ++j) { u32x2 o; o[0] = cvt_pk_bf16(v[j][0], v[j][1]); o[1] = cvt_pk_bf16(v[j][2], v[j][3]); *(u32x2*)(xb + (size_t)r * 1024 + lane * 4 + 256 * j) = o; }
        }
        if (yf) {
#pragma unroll
            for (int j = 0; j < 4; ++j) *(f32x4*)(yf + (size_t)r * 1024 + lane * 4 + 256 * j) = v[j];
        }
        if (wl >= 0) {
            float p[16];
#pragma unroll
            for (int q = 0; q < 16; ++q) p[q] = 0.f;
#pragma unroll
            for (int j = 0; j < 4; ++j)
#pragma unroll
                for (int e = 0; e < 4; ++e) {
                    const LAS f32x4* wp = (const LAS f32x4*)(wt + ((j * 4 + e) * 64 + lane) * 16);
                    const float xv = v[j][e];
#pragma unroll
                    for (int q4 = 0; q4 < 4; ++q4) { const f32x4 w = wp[q4]; p[q4 * 4] += xv * w[0]; p[q4 * 4 + 1] += xv * w[1]; p[q4 * 4 + 2] += xv * w[2]; p[q4 * 4 + 3] += xv * w[3]; }
                    if (e == 3) __builtin_amdgcn_sched_barrier(0);
                }
            float ov = reduce_scatter<16>(p, lane);
            ov += __shfl_xor(ov, 16); ov += __shfl_xor(ov, 32);
            if (lane < 16) ab[(size_t)r * 16 + bitrev(lane, 4)] = ov;
        }
    }
}

__device__ __forceinline__ void mixed_phase(const Params& P, int l) {
    const bf16_t* up = slotp(P, 1); bf16_t* mx = slotp(P, 6);
    const int nitems = (1024 + 16) * 128;
    for (int idx = blockIdx.x * 512 + opaque_tid(); idx < nitems; idx += gridDim.x * 512) {
        const int blk = idx >> 7, c = (idx & 127) * 8;
        int rbase, t0, sb; bool smp;
        if (blk < 1024) { rbase = (blk >> 7) * 4096; t0 = (blk & 127) * 32; smp = false; sb = 0; }
        else { sb = blk - 1024; rbase = RP + sb * 32; t0 = 0; smp = true; }
        const int w = 2 << (c >> 8);
        const float* hist = P.state_pool + ((size_t)(l * 16 + sb) * 15) * 1024 + c;
        auto ldu = [&](int t, float (&o)[8]) __attribute__((always_inline)) {
            if (t >= 0) { unpack8(*(const u32x4*)(up + (size_t)(rbase + t) * 1024 + c), o); }
            else if (smp) { const f32x4 a = *(const f32x4*)(hist + (size_t)(15 + t) * 1024), b2 = *(const f32x4*)(hist + (size_t)(15 + t) * 1024 + 4);
#pragma unroll
                for (int e = 0; e < 4; ++e) { o[e] = a[e]; o[4 + e] = b2[e]; } }
            else {
#pragma unroll
                for (int e = 0; e < 8; ++e) o[e] = 0.f; }
        };
        float s[8];
#pragma unroll
        for (int e = 0; e < 8; ++e) s[e] = 0.f;
        for (int d0 = 1; d0 < w; d0 += 4) {
            float hb[4][8];
#pragma unroll
            for (int q = 0; q < 4; ++q) { if (d0 + q < w) ldu(t0 - d0 - q, hb[q]); else {
#pragma unroll
                for (int e = 0; e < 8; ++e) hb[q][e] = 0.f; } }
#pragma unroll
            for (int q = 0; q < 4; ++q)
#pragma unroll
                for (int e = 0; e < 8; ++e) s[e] += hb[q][e];
        }
        float cur[4][8], old[4][8], ncur[4][8], nold[4][8];
#pragma unroll
        for (int q = 0; q < 4; ++q) { ldu(t0 + q, cur[q]); ldu(t0 + q - w + 1, old[q]); }
#pragma unroll
        for (int i0 = 0; i0 < 32; i0 += 4) {
            if (i0 + 4 < 32) {
#pragma unroll
                for (int q = 0; q < 4; ++q) { ldu(t0 + i0 + 4 + q, ncur[q]); ldu(t0 + i0 + 4 + q - w + 1, nold[q]); }
            }
#pragma unroll
            for (int q = 0; q < 4; ++q) {
                const int i = i0 + q;
                const float inv = 1.f / (smp ? (float)w : (float)min(w, t0 + i + 1));
                f32x4 o0, o1;
#pragma unroll
                for (int e = 0; e < 8; ++e) s[e] += cur[q][e];
#pragma unroll
                for (int e = 0; e < 4; ++e) { o0[e] = s[e] * inv - cur[q][e]; o1[e] = s[4 + e] * inv - cur[q][4 + e]; }
                *(u32x4*)(mx + (size_t)(rbase + t0 + i) * 1024 + c) = pack8(o0, o1);
#pragma unroll
                for (int e = 0; e < 8; ++e) s[e] -= old[q][e];
            }
#pragma unroll
            for (int q = 0; q < 4; ++q)
#pragma unroll
                for (int e = 0; e < 8; ++e) { cur[q][e] = ncur[q][e]; old[q][e] = nold[q][e]; }
        }
    }
}

template <int N> __device__ __forceinline__ float reduce_scatter(float (&v)[N], int lane) {
    int n = N;
#pragma unroll
    for (int s = 0; (1 << s) < N; ++s) {
        const unsigned mk = ((lane >> s) & 1) ? 0xffffffffu : 0u; const int hn = n >> 1;
#pragma unroll
        for (int j = 0; j < (N >> (s + 1)); ++j) { const unsigned ua = __float_as_uint(v[j]), ub = __float_as_uint(v[j + hn]);
            const float send = __uint_as_float((ua & mk) | (ub & ~mk)); const float keep = __uint_as_float((ub & mk) | (ua & ~mk)); v[j] = keep + __shfl_xor(send, 1 << s); }
        n = hn;
    }
    return v[0];
}
__device__ __forceinline__ int bitrev(int x, int bits) { int r = 0; for (int i = 0; i < bits; ++i) r |= ((x >> i) & 1) << (bits - 1 - i); return r; }

#define P2_BAR() asm volatile("s_waitcnt lgkmcnt(0)\n\ts_barrier" ::: "memory")
__device__ __forceinline__ void delta_pre_phase(const Params& P, int l, LAS unsigned char* lds0) {
    const int tid = opaque_tid(), half = tid >> 8, th0 = tid & 255;
    LAS unsigned char* lds = lds0 + half * 65536;
    LAS float* Lf = (LAS float*)lds;
    LAS bf16_t* kb = (LAS bf16_t*)(lds + 16384);
    LAS bf16_t* qb = (LAS bf16_t*)(lds + 33792);
    LAS float* gc = (LAS float*)(lds + 55296);
    LAS float* be = gc + 64; LAS float* eg = gc + 128; LAS float* rnk = gc + 192; LAS float* rnq = gc + 256;
    LAS float* red = gc + 320;
    const bf16_t* halo = (const bf16_t*)(P.ws + WS_HALO);
    const float* ab = (const float*)(P.ws + WS_AB);
    float* gtot = (float*)(P.ws + WS_GTOT);
    bf16_t* qs = slotp(P, 2); bf16_t* ks = slotp(P, 3); bf16_t* vs = slotp(P, 4); bf16_t* ws_ = slotp(P, 1); bf16_t* ats = slotp(P, 6);
    const float* cw = P.conv_w + (size_t)l * 4 * 3072;
    for (int pair = blockIdx.x; pair < NCHH / 2; pair += gridDim.x) {
        int th = th0; asm volatile("" : "+v"(th));
        const int wv4 = th >> 6, lane = th & 63;
        const int ch = pair * 2 + half;
        const bool smp = ch >= 4096;
        const int chunk = ch >> 3, h = ch & 7, sb = smp ? chunk - 512 : 0, n = chunk & 63;
        const int r0 = smp ? RP + sb * 32 : chunk * 64, nvalid = smp ? 32 : 64;
        bf16_t* qblk = qs + (size_t)ch * 8192; bf16_t* kblk = ks + (size_t)ch * 8192; bf16_t* vblk = vs + (size_t)ch * 8192;
        if (wv4 == 0) {
            const bool valid = lane < nvalid; const int r = r0 + (valid ? lane : 0);
            const float braw = ab[(size_t)r * 16 + h], araw = ab[(size_t)r * 16 + 8 + h];
            const float beta = valid ? sigm(braw) : 0.f;
            float gg = valid ? -__expf(P.a_log[l * 8 + h]) * softplus(araw + P.dt_bias[l * 8 + h]) : 0.f;
#pragma unroll
            for (int d = 1; d < 64; d <<= 1) { const float o = __shfl_up(gg, d); if (lane >= d) gg += o; }
            gc[lane] = gg; be[lane] = beta; eg[lane] = __expf(gg); rnk[lane] = __expf(__shfl(gg, 63) - gg);
            if (lane == 63) gtot[ch] = __expf(gg);
        }
        const int col = th & 127;
        const float* sconv = P.state_conv + (size_t)(l * 16 + sb) * 3 * 3072;
        auto halo_val = [&](int sec, int hi) __attribute__((always_inline)) -> float {
            const int cc = sec * 1024 + h * 128 + col;
            if (smp) return sconv[(size_t)hi * 3072 + cc];
            if (n == 0) return 0.f;
            return bf2f(halo[((size_t)chunk * 3 + hi) * 3072 + cc]);
        };
        const int rh = th >> 7;
        LAS float* rk = gc + 256; LAS float* rq = gc + 320;
        float qx[32], x[64];
        {
            const int ccq = h * 128 + col, sec = (th < 128) ? 1 : 2, cck = sec * 1024 + h * 128 + col;
            const float qw0 = cw[ccq], qw1 = cw[3072 + ccq], qw2 = cw[2 * 3072 + ccq], qw3 = cw[3 * 3072 + ccq];
            const float kw0 = cw[cck], kw1 = cw[3072 + cck], kw2 = cw[2 * 3072 + cck], kw3 = cw[3 * 3072 + cck];
            float qm3, qm2, qm1;
            if (rh == 0) { qm3 = halo_val(0, 0); qm2 = halo_val(0, 1); qm1 = halo_val(0, 2); }
            else { qm3 = bf2f(qblk[29 * 128 + col]); qm2 = bf2f(qblk[30 * 128 + col]); qm1 = bf2f(qblk[31 * 128 + col]); }
            float km3 = halo_val(sec, 0), km2 = halo_val(sec, 1), km1 = halo_val(sec, 2);
            const GAS bf16_t* pq = (const GAS bf16_t*)(qblk + (rh * 32) * 128 + col);
            const GAS bf16_t* pk = (const GAS bf16_t*)((th < 128 ? kblk : vblk) + col);
#pragma unroll
            for (int i = 0; i < 32; ++i) qx[i] = bf2f(pq[i * 128]);
#pragma unroll
            for (int i = 0; i < 64; ++i) x[i] = bf2f(pk[i * 128]);
            if (smp) {
                const int nv = nvalid - rh * 32;
#pragma unroll
                for (int i = 0; i < 32; ++i) qx[i] = (i < nv) ? qx[i] : 0.f;
#pragma unroll
                for (int i = 0; i < 64; ++i) x[i] = (i < nvalid) ? x[i] : 0.f;
            }
#pragma unroll
            for (int i = 0; i < 32; ++i) { const float x0 = qx[i];
                const float y = qw0 * qm3 + qw1 * qm2 + qw2 * qm1 + qw3 * x0; const float sv = silu(y); qx[i] = sv; qb[(rh * 32 + i) * 136 + col] = f2bf(sv); qm3 = qm2; qm2 = qm1; qm1 = x0; }
#pragma unroll
            for (int i = 0; i < 64; ++i) { const float x0 = x[i];
                const float y = kw0 * km3 + kw1 * km2 + kw2 * km1 + kw3 * x0; x[i] = silu(y); km3 = km2; km2 = km1; km1 = x0; }
        }
        if (th < 128) {
#pragma unroll
            for (int i = 0; i < 64; ++i) kb[i * 136 + col] = f2bf(x[i]);
        }
        P2_BAR();
        const int m = wv4, ln = lane & 15, lq = lane >> 4;
        f32x4 aL[4], aA[4];
        {
            f32x4 aQ = (f32x4){0.f, 0.f, 0.f, 0.f};
            bf16x8 ak[4], aq[4];
#pragma unroll
            for (int ksx = 0; ksx < 4; ++ksx) { const int ko = 32 * ksx + lq * 8;
                ak[ksx] = *(const LAS bf16x8*)(kb + (16 * m + ln) * 136 + ko); aq[ksx] = *(const LAS bf16x8*)(qb + (16 * m + ln) * 136 + ko); }
#pragma unroll
            for (int ksx = 0; ksx < 4; ++ksx) aQ = mfma16(aq[ksx], aq[ksx], aQ);
#pragma unroll
            for (int nn = 0; nn < 4; ++nn) {
                aL[nn] = (f32x4){0.f, 0.f, 0.f, 0.f}; aA[nn] = (f32x4){0.f, 0.f, 0.f, 0.f};
                if (nn <= m) {
#pragma unroll
                    for (int ksx = 0; ksx < 4; ++ksx) {
                        const bf16x8 bk = *(const LAS bf16x8*)(kb + (16 * nn + ln) * 136 + 32 * ksx + lq * 8);
                        aL[nn] = mfma16(ak[ksx], bk, aL[nn]); aA[nn] = mfma16(bk, aq[ksx], aA[nn]);
                    }
                }
                if (nn == m && (ln >> 2) == lq) {
                    const int rg = ln & 3;
                    const float gk = rg == 0 ? aL[nn][0] : rg == 1 ? aL[nn][1] : rg == 2 ? aL[nn][2] : aL[nn][3];
                    const float gq = rg == 0 ? aQ[0] : rg == 1 ? aQ[1] : rg == 2 ? aQ[2] : aQ[3];
                    rk[16 * m + ln] = rsqrtf(gk + 1e-6f); rq[16 * m + ln] = rsqrtf(gq + 1e-6f) * 0.08838834764831845f;
                }
            }
        }
        P2_BAR();
        {
            bf16_t* at = ats + (size_t)ch * 4096;
#pragma unroll
            for (int nn = 0; nn < 4; ++nn) {
                const int j = 16 * nn + ln; const float gj = gc[j], rkj = rk[j];
#pragma unroll
                for (int rg = 0; rg < 4; ++rg) {
                    const int i = 16 * m + lq * 4 + rg;
                    const float d = (i >= j) ? __expf(gc[i] - gj) * rkj : 0.f;
                    Lf[i * 64 + (j & 3) * 16 + (j >> 2)] = (i > j) ? be[i] * rk[i] * aL[nn][rg] * d : 0.f;
                }
                {
                    const int i2 = 16 * m + ln, j2 = 16 * nn + 4 * lq; const float gi = gc[i2], rqi = rq[i2];
                    float av[4];
#pragma unroll
                    for (int rg = 0; rg < 4; ++rg) av[rg] = (i2 >= j2 + rg) ? rqi * aA[nn][rg] * __expf(gi - gc[j2 + rg]) * rk[j2 + rg] : 0.f;
                    u32x2 o; o[0] = cvt_pk_bf16(av[0], av[1]); o[1] = cvt_pk_bf16(av[2], av[3]);
                    *(u32x2*)(at + i2 * 64 + j2) = o;
                }
            }
        }
        if (th < 128) {
            u32x4 o[8];
#pragma unroll
            for (int i = 0; i < 64; i += 2) {
                const float k0 = x[i] * rk[i], k1 = x[i + 1] * rk[i + 1];
                o[i >> 3][(i >> 1) & 3] = cvt_pk_bf16(k0 * rnk[i], k1 * rnk[i + 1]);
                x[i] = k0 * be[i] * eg[i]; x[i + 1] = k1 * be[i + 1] * eg[i + 1];
            }
#pragma unroll
            for (int e = 0; e < 8; ++e) *(u32x4*)(kblk + col * 64 + e * 8) = o[e];
        } else {
#pragma unroll
            for (int i = 0; i < 64; ++i) x[i] *= be[i];
        }
        {
#pragma unroll
            for (int e = 0; e < 4; ++e) {
                const int pc = th + 256 * e, row = pc >> 4, c8 = (pc & 15) * 8;
                float qv[8]; unpack8(*(const LAS u32x4*)(qb + row * 136 + c8), qv);
                const float sc = rq[row] * eg[row];
                f32x4 o0, o1;
#pragma unroll
                for (int q = 0; q < 4; ++q) { o0[q] = qv[q] * sc; o1[q] = qv[4 + q] * sc; }
                *(u32x4*)(qblk + row * 128 + c8) = pack8(o0, o1);
            }
        }
        P2_BAR();
        LAS bf16_t* Thi = (LAS bf16_t*)(lds + 36864);
        {
            const int c = th >> 2, t4 = th & 3;
            float z[16];
#pragma unroll
            for (int q = 0; q < 16; ++q) z[q] = 0.f;
#pragma unroll
            for (int i = 0; i < 64; ++i) {
                float p = 0.f;
#pragma unroll
                for (int q4 = 0; q4 < (i + 15) / 16; ++q4) {
                    const f32x4 lv = *(const LAS f32x4*)(Lf + i * 64 + t4 * 16 + q4 * 4);
                    p += lv[0] * z[q4 * 4]; p += lv[1] * z[q4 * 4 + 1]; p += lv[2] * z[q4 * 4 + 2]; p += lv[3] * z[q4 * 4 + 3];
                }
                p += __builtin_bit_cast(float, __builtin_amdgcn_update_dpp(0, __builtin_bit_cast(int, p), 0xB1, 0xF, 0xF, true));
                p += __builtin_bit_cast(float, __builtin_amdgcn_update_dpp(0, __builtin_bit_cast(int, p), 0x4E, 0xF, 0xF, true));
                const float y = ((i == c) ? 1.f : 0.f) - p;
                const bool mine = t4 == (i & 3);
                z[i >> 2] = mine ? y : z[i >> 2];
                if (mine) Thi[i * 72 + c] = f2bf(y);
                if ((i & 3) == 3) __builtin_amdgcn_sched_barrier(0);
            }
        }
        P2_BAR();
        {
            LAS unsigned char* rT = lds;
#pragma unroll
            for (int e = 0; e < 8; ++e) { u32x4 o;
#pragma unroll
                for (int q = 0; q < 4; ++q) o[q] = cvt_pk_bf16(x[e * 8 + 2 * q], x[e * 8 + 2 * q + 1]);
                *(LAS u32x4*)(rT + th * 144 + e * 16) = o; }
        }
        P2_BAR();
        {
            LAS unsigned char* rT = lds;
            bf16_t* wblk = ws_ + (size_t)ch * 8192;
            bf16x8 th_[2];
#pragma unroll
            for (int ksx = 0; ksx < 2; ++ksx) th_[ksx] = *(const LAS bf16x8*)(Thi + (16 * wv4 + ln) * 72 + 32 * ksx + 8 * lq);
#pragma unroll
            for (int nt8 = 0; nt8 < 8; ++nt8) {
                f32x4 acc = (f32x4){0.f, 0.f, 0.f, 0.f};
#pragma unroll
                for (int ksx = 0; ksx < 2; ++ksx) {
                    const bf16x8 bv = *(const LAS bf16x8*)(rT + (128 + 16 * nt8 + ln) * 144 + (32 * ksx + 8 * lq) * 2);
                    acc = mfma16(th_[ksx], bv, acc);
                }
                u32x2 o; o[0] = cvt_pk_bf16(acc[0], acc[1]); o[1] = cvt_pk_bf16(acc[2], acc[3]);
                *(u32x2*)(vblk + (16 * nt8 + ln) * 64 + 16 * wv4 + 4 * lq) = o;
            }
#pragma unroll
            for (int mm = 0; mm < 2; ++mm) {
                const int mt = 2 * wv4 + mm;
                bf16x8 ak[2];
#pragma unroll
                for (int ksx = 0; ksx < 2; ++ksx) ak[ksx] = *(const LAS bf16x8*)(rT + (16 * mt + ln) * 144 + (32 * ksx + 8 * lq) * 2);
#pragma unroll
                for (int nt4 = 0; nt4 < 4; ++nt4) {
                    f32x4 acc = (f32x4){0.f, 0.f, 0.f, 0.f};
#pragma unroll
                    for (int ksx = 0; ksx < 2; ++ksx) {
                        const bf16x8 bh = *(const LAS bf16x8*)(Thi + (16 * nt4 + ln) * 72 + 32 * ksx + 8 * lq);
                        acc = mfma16(ak[ksx], bh, acc);
                    }
                    u32x2 o; o[0] = cvt_pk_bf16(acc[0], acc[1]); o[1] = cvt_pk_bf16(acc[2], acc[3]);
                    *(u32x2*)(wblk + (16 * nt4 + ln) * 128 + 16 * mt + 4 * lq) = o;
                }
            }
        }
        P2_BAR();
    }
}

#undef P2_BAR
__device__ __forceinline__ void scan_phase(const Params& P, int l, LAS unsigned char* lds) {
    constexpr int W_OFF = 0, QD_OFF = 17408, KT_OFF = 34816, AT_OFF = 53248, OP_BYTES = 62464, ST_OFF = 2 * OP_BYTES, VT_OFF = ST_OFF + 8704;
    const int tid = opaque_tid(), lane = tid & 63, wv = tid >> 6, m = wv & 3, nt = wv >> 2;
    const bf16_t* qs = slotp(P, 2); const bf16_t* ks = slotp(P, 3); bf16_t* vs = slotp(P, 4); const bf16_t* wsl = slotp(P, 1); const bf16_t* ats = slotp(P, 6);
    const float* gtot = (const float*)(P.ws + WS_GTOT);
    const int ln = lane & 15, lq = lane >> 4;
    const int cid = (int)*(volatile LAS unsigned*)(lds + LDS_ST + 8);
    const bool remap = gridDim.x == 256u;
    const int it0 = (cid & 7) * 32 + (cid >> 3);
    for (int itx = blockIdx.x; itx < 768; itx += gridDim.x) {
        const int it = (remap && itx < 256) ? it0 : itx;
        int b, h, part, nsteps, ch0; bool smp;
        if (it < 256) { const int bh = it >> 2; part = it & 3; b = bh >> 3; h = bh & 7; nsteps = 64; ch0 = (b * 64) * 8 + h; smp = false; }
        else { const int j = it - 256, bh = j >> 2; part = j & 3; b = bh >> 3; h = bh & 7; nsteps = 1; ch0 = (512 + b) * 8 + h; smp = true; }
        f32x4 accS[2];
        float* sout = P.out + (smp ? O_DELTAS + ((size_t)(l * 16 + b) * 8 + h) * 16384 : O_DELTAP + ((size_t)(l * 8 + b) * 8 + h) * 16384);
#pragma unroll
        for (int t = 0; t < 2; ++t)
#pragma unroll
            for (int rg = 0; rg < 4; ++rg) {
                const int dk = 16 * wv + lq * 4 + rg, dv = part * 32 + 16 * t + ln;
                accS[t][rg] = smp ? P.state_delta[((size_t)(l * 16 + b) * 8 + h) * 16384 + dk * 128 + dv] : 0.f;
            }
        auto write_st = [&]() __attribute__((always_inline)) {
#pragma unroll
            for (int t = 0; t < 2; ++t) { u32x2 o; o[0] = cvt_pk_bf16(accS[t][0], accS[t][1]); o[1] = cvt_pk_bf16(accS[t][2], accS[t][3]);
                *(LAS u32x2*)(lds + ST_OFF + (16 * t + ln) * 272 + (16 * wv + lq * 4) * 2) = o; }
        };
        u32x4 pw[2], pq[2], pk[2], pa;
        auto gload = [&](int ch) __attribute__((always_inline)) {
            const u32x4* gw = (const u32x4*)(wsl + (size_t)ch * 8192); const u32x4* gq = (const u32x4*)(qs + (size_t)ch * 8192); const u32x4* gk = (const u32x4*)(ks + (size_t)ch * 8192);
            const u32x4* ga = (const u32x4*)(ats + (size_t)ch * 4096);
#pragma unroll
            for (int e = 0; e < 2; ++e) { pw[e] = gw[tid + 512 * e]; pq[e] = gq[tid + 512 * e]; pk[e] = gk[tid + 512 * e]; }
            pa = ga[tid];
        };
        auto lstore = [&](int bo) __attribute__((always_inline)) {
#pragma unroll
            for (int e = 0; e < 2; ++e) { const int p = tid + 512 * e;
                *(LAS u32x4*)(lds + bo + W_OFF + (p >> 4) * 272 + (p & 15) * 16) = pw[e];
                *(LAS u32x4*)(lds + bo + QD_OFF + (p >> 4) * 272 + (p & 15) * 16) = pq[e];
                *(LAS u32x4*)(lds + bo + KT_OFF + (p >> 3) * 144 + (p & 7) * 16) = pk[e]; }
            *(LAS u32x4*)(lds + bo + AT_OFF + (tid >> 3) * 144 + (tid & 7) * 16) = pa;
        };
#define LBAR() asm volatile("s_waitcnt lgkmcnt(0)\n\ts_barrier" ::: "memory")
        gload(ch0);
        write_st();
        lstore(0);
        bf16_t* up = vs + (size_t)ch0 * 8192 + (size_t)(part * 32 + 16 * nt + ln) * 64 + 16 * m + lq * 4;
        u32x2 uv = *(const u32x2*)up;
        float gt = gtot[ch0];
        if (nsteps > 1) gload(ch0 + 8);
        LBAR();
        for (int n = 0; n < nsteps; ++n) {
            const int ch = ch0 + n * 8;
            const int bo = (n & 1) * OP_BYTES;
            u32x2 uvn = uv; float gtn = gt;
            if (n + 1 < nsteps) {
                lstore(bo ^ OP_BYTES);
                uvn = *(const u32x2*)(up + 8 * 8192); gtn = gtot[ch + 8];
                if (n + 2 < nsteps) gload(ch + 16);
            }
            f32x4 accV = (f32x4){0.f, 0.f, 0.f, 0.f}, accQ = (f32x4){0.f, 0.f, 0.f, 0.f};
#pragma unroll
            for (int ksx = 0; ksx < 4; ++ksx) {
                const int ko = (32 * ksx + lq * 8) * 2;
                const bf16x8 aw = *(const LAS bf16x8*)(lds + bo + W_OFF + (16 * m + ln) * 272 + ko);
                const bf16x8 aq = *(const LAS bf16x8*)(lds + bo + QD_OFF + (16 * m + ln) * 272 + ko);
                const bf16x8 bs = *(const LAS bf16x8*)(lds + ST_OFF + (16 * nt + ln) * 272 + ko);
                accV = mfma16(aw, bs, accV); accQ = mfma16(aq, bs, accQ);
            }
            {
                const float u0 = __uint_as_float(uv[0] << 16), u1 = __uint_as_float(uv[0] & 0xffff0000u), u2 = __uint_as_float(uv[1] << 16), u3 = __uint_as_float(uv[1] & 0xffff0000u);
                u32x2 o; o[0] = cvt_pk_bf16(u0 - accV[0], u1 - accV[1]); o[1] = cvt_pk_bf16(u2 - accV[2], u3 - accV[3]);
                *(LAS u32x2*)(lds + VT_OFF + (16 * nt + ln) * 144 + (16 * m + lq * 4) * 2) = o;
            }
            LBAR();
#pragma unroll
            for (int ksx = 0; ksx < 2; ++ksx) {
                const int ko = (32 * ksx + lq * 8) * 2;
                const bf16x8 aa = *(const LAS bf16x8*)(lds + bo + AT_OFF + (16 * m + ln) * 144 + ko);
                const bf16x8 bv = *(const LAS bf16x8*)(lds + VT_OFF + (16 * nt + ln) * 144 + ko);
                accQ = mfma16(aa, bv, accQ);
            }
            { u32x2 o; o[0] = cvt_pk_bf16(accQ[0], accQ[1]); o[1] = cvt_pk_bf16(accQ[2], accQ[3]); *(u32x2*)up = o; }
#pragma unroll
            for (int t = 0; t < 2; ++t) {
                accS[t] = accS[t] * gt;
#pragma unroll
                for (int ksx = 0; ksx < 2; ++ksx) {
                    const int ko = (32 * ksx + lq * 8) * 2;
                    const bf16x8 ak = *(const LAS bf16x8*)(lds + bo + KT_OFF + (16 * wv + ln) * 144 + ko);
                    const bf16x8 bv = *(const LAS bf16x8*)(lds + VT_OFF + (16 * t + ln) * 144 + ko);
                    accS[t] = mfma16(ak, bv, accS[t]);
                }
            }
            write_st();
            LBAR();
            uv = uvn; gt = gtn; up += 8 * 8192;
        }
#undef LBAR
        __syncthreads();
#pragma unroll
        for (int t = 0; t < 2; ++t)
#pragma unroll
            for (int rg = 0; rg < 4; ++rg) { const int dk = 16 * wv + lq * 4 + rg, dv = part * 32 + 16 * t + ln; sout[dk * 128 + dv] = accS[t][rg]; }
    }
}

__device__ __forceinline__ void merge_phase(const Params& P, int l, LAS unsigned char* lds) {
    const int tid = opaque_tid();
    const bf16_t* os = slotp(P, 4); const bf16_t* zs = slotp(P, 5); bf16_t* mg = slotp(P, 2);
    const bf16_t* ma = (const bf16_t*)P.out; const bf16_t* gb = ma + (size_t)R * 1024;
    const float* gain = P.o_gain + l * 128;
    const int j = tid >> 3, g8 = tid & 7;
    u32x4 pre[2];
    u32x4 zr[2], gr[2], mr[2], nzr[2], ngr[2], nmr[2]; f32x4 gn[4];
#pragma unroll
    for (int e = 0; e < 2; ++e) { gn[2 * e] = *(const f32x4*)(gain + g8 * 16 + e * 8); gn[2 * e + 1] = *(const f32x4*)(gain + g8 * 16 + e * 8 + 4); }
    auto item_off = [&](int c2) __attribute__((always_inline)) -> size_t {
        const bool sm = c2 >= 4096; const int ck = c2 >> 3, hh = c2 & 7;
        const int rr0 = sm ? RP + (ck - 512) * 32 : ck * 64, nv = sm ? 32 : 64;
        return (size_t)(rr0 + (j < nv ? j : 0)) * 1024 + hh * 128 + g8 * 16;
    };
    if ((int)blockIdx.x < NCHH) { const u32x4* src = (const u32x4*)(os + (size_t)blockIdx.x * 8192); pre[0] = src[tid]; pre[1] = src[tid + 512];
        const size_t o0 = item_off(blockIdx.x);
#pragma unroll
        for (int e = 0; e < 2; ++e) { zr[e] = *(const u32x4*)(zs + o0 + e * 8); gr[e] = *(const u32x4*)(gb + o0 + e * 8); mr[e] = *(const u32x4*)(ma + o0 + e * 8); } }
    for (int ch = blockIdx.x; ch < NCHH; ch += gridDim.x) {
        const bool smp = ch >= 4096; const int chunk = ch >> 3, h = ch & 7;
        const int r0 = smp ? RP + (chunk - 512) * 32 : chunk * 64, nvalid = smp ? 32 : 64;
#pragma unroll
        for (int e = 0; e < 2; ++e) { const int p = tid + 512 * e; const int dvr = p >> 3; *(LAS u32x4*)(lds + ((dvr & 15) * 8 + (dvr >> 4)) * 144 + (p & 7) * 16) = pre[e]; }
        if (ch + (int)gridDim.x < NCHH) {
            const int c2 = ch + gridDim.x;
            const u32x4* src = (const u32x4*)(os + (size_t)c2 * 8192); pre[0] = src[tid]; pre[1] = src[tid + 512];
            const size_t o2 = item_off(c2);
#pragma unroll
            for (int e = 0; e < 2; ++e) { nzr[e] = *(const u32x4*)(zs + o2 + e * 8); ngr[e] = *(const u32x4*)(gb + o2 + e * 8); nmr[e] = *(const u32x4*)(ma + o2 + e * 8); }
        }
        const size_t off = (size_t)(r0 + (j < nvalid ? j : 0)) * 1024 + h * 128 + g8 * 16;
        __syncthreads();
        float o[16]; float ss = 0.f;
#pragma unroll
        for (int d = 0; d < 16; ++d) { o[d] = bf2f(*(const LAS bf16_t*)(lds + (d * 8 + g8) * 144 + j * 2)); ss += o[d] * o[d]; }
        ss += __shfl_xor(ss, 1); ss += __shfl_xor(ss, 2); ss += __shfl_xor(ss, 4);
        const float rn = rsqrtf(ss * (1.f / 128.f) + 1e-6f);
        if (j < nvalid) {
#pragma unroll
            for (int e = 0; e < 2; ++e) {
                float zv[8], gv[8], mv[8];
                unpack8(zr[e], zv); unpack8(gr[e], gv); unpack8(mr[e], mv);
                const f32x4 g0 = gn[2 * e], g1 = gn[2 * e + 1];
                f32x4 r0v, r1v;
#pragma unroll
                for (int q = 0; q < 4; ++q) {
                    r0v[q] = mv[q] + sigm(gv[q]) * (o[e * 8 + q] * rn * g0[q] * silu(zv[q]));
                    r1v[q] = mv[4 + q] + sigm(gv[4 + q]) * (o[e * 8 + 4 + q] * rn * g1[q] * silu(zv[4 + q]));
                }
                *(u32x4*)(mg + off + e * 8) = pack8(r0v, r1v);
            }
        }
#pragma unroll
        for (int e = 0; e < 2; ++e) { zr[e] = nzr[e]; gr[e] = ngr[e]; mr[e] = nmr[e]; }
        __syncthreads();
    }
}

#ifndef DBG_SLOTMASK
#define DBG_SLOTMASK 0
#endif
#ifndef DBG_RANGE
#define DBG_RANGE (RP * 1024)
#endif
template <int S> __device__ __forceinline__ void run_stage(const Params& P, int l, LAS unsigned char* lds) {
    bf16_t* wb = wbf(P);
    if constexpr (S == 11) {
        ln_phase(P, P.x_prompt, P.x_sample, P.ln_in_g, P.ln_in_b, slotp(P, 0), nullptr, 0, lds);
        __syncthreads();
        convert_weights(P, 0, lds);
    } else if constexpr (S == 12) {
        const size_t n = O_DELTAS + 2ull * 16 * 8 * 16384;
        const float* ab = (const float*)(P.ws + WS_AB);
        constexpr int SM = DBG_SLOTMASK;
        for (size_t i = (size_t)blockIdx.x * 512 + opaque_tid(); i < n; i += (size_t)gridDim.x * 512) {
            float v = 0.f;
            if ((SM & 256) && i < (size_t)R * 1024) { v = P.out[i]; if (!(fabsf(v) < 1e30f)) v = 777.f; }
            if ((SM & 1024) && i >= (size_t)R * 1024) { v = P.out[i]; if (!(fabsf(v) < 1e30f)) v = 777.f; }
            const size_t si = i % ((size_t)DBG_RANGE);
#pragma unroll
            for (int q = 0; q < 7; ++q) if ((SM >> q) & 1) { float w = bf2f(slotp(P, q)[si]); if (!(fabsf(w) < 1e30f)) w = 777.f; v += w * (float)(q + 1); }
            if (SM & 128) { float w = bf2f(wbf(P)[i % WB_E]); if (!(fabsf(w) < 1e30f)) w = 777.f; v += w; }
            if ((SM & 512) && i < (size_t)R * 16) { float w = ab[i]; if (!(fabsf(w) < 1e30f)) w = 777.f; v += w; }
            P.out[i] = v;
        }
    } else if constexpr (S == 13) {
        const size_t n = O_DELTAS + 2ull * 16 * 8 * 16384;
        for (size_t i = (size_t)blockIdx.x * 512 + opaque_tid(); i < n; i += (size_t)gridDim.x * 512) { const float v = P.out[i]; if (!(fabsf(v) < 1e30f)) P.out[i] = 777.f; }
    } else if constexpr (S == 0) { EpiIn E; E.up = slotp(P, 1); E.q = slotp(P, 2); E.z = slotp(P, 5); E.ga = (bf16_t*)P.out; E.halo = (bf16_t*)(P.ws + WS_HALO);
        E.pool_p = P.out + O_POOLP + (size_t)l * 8 * 15 * 1024; E.conv_p = P.out + O_CONVP + (size_t)l * 8 * 3 * 3072;
        E.pool_s = P.out + O_POOLS + (size_t)l * 16 * 15 * 1024; E.conv_s = P.out + O_CONVS + (size_t)l * 16 * 3 * 3072;
        run_gemm(lds, slotp(P, 0), 1024, 0, wb + WIN_E, R, 7168, 1024, E);
    } else if constexpr (S == 1) { mixed_phase(P, l);
    } else if constexpr (S == 2) { EpiPool E; E.ga = (bf16_t*)P.out; E.scale = P.pool_scale + l * 1024; run_gemm(lds, slotp(P, 6), 1024, 256, wb + WPOOL_E, R, 1024, 256, E);
    } else if constexpr (S == 3) { delta_pre_phase(P, l, lds);
    } else if constexpr (S == 4) { scan_phase(P, l, lds);
    } else if constexpr (S == 5) { merge_phase(P, l, lds);
    } else if constexpr (S == 6) { EpiRes E; E.res = slotp(P, 0); E.bias = nullptr; E.out = slotp(P, 5); E.part = (float*)(P.ws + WS_PART);
        run_gemm(lds, slotp(P, 2), 1024, 0, wb + WOUT_E, RP, 1024, 1024, E);
        E.res += (size_t)RP * 1024; E.out += (size_t)RP * 1024;
        run_gemm(lds, slotp(P, 2) + (size_t)RP * 1024, 1024, 0, wb + WOUT_E, RS, 1024, 1024, E, 4);
    } else if constexpr (S == 7) { ln_phase(P, nullptr, nullptr, P.ln1_g + l * 1024, P.ln1_b + l * 1024, slotp(P, 0), nullptr, -1, lds, (const float*)(P.ws + WS_PART), slotp(P, 5));
    } else if constexpr (S == 8) { EpiFF1 E; E.h = slotp(P, 1); E.bias = P.b_ff1 + l * 4096; run_gemm(lds, slotp(P, 0), 1024, 0, wb + WFF1_E, R, 4096, 1024, E);
    } else if constexpr (S == 9) { EpiRes E; E.res = slotp(P, 0); E.bias = P.b_ff2 + l * 1024; E.out = slotp(P, 5); E.part = (float*)(P.ws + WS_PART);
        run_gemm(lds, slotp(P, 1), 4096, 0, wb + WFF2_E, RP, 1024, 4096, E);
        E.res += (size_t)RP * 1024; E.out += (size_t)RP * 1024;
        run_gemm(lds, slotp(P, 1) + (size_t)RP * 4096, 4096, 0, wb + WFF2_E, RS, 1024, 4096, E, 4);
    } else {
        if (l == 0) { ln_phase(P, nullptr, nullptr, P.ln2_g, P.ln2_b, slotp(P, 0), nullptr, 1, lds, (const float*)(P.ws + WS_PART), slotp(P, 5)); __syncthreads(); convert_weights(P, 1, lds); }
        else ln_phase(P, nullptr, nullptr, P.ln2_g + 1024, P.ln2_b + 1024, nullptr, P.out, -1, lds, (const float*)(P.ws + WS_PART), slotp(P, 5));
    }
}
constexpr int NPHASES = 23;
__device__ __forceinline__ void run_phase(const Params& P, int ph, LAS unsigned char* lds) {
    if (ph == 0) { run_stage<11>(P, 0, lds); return; }
    const int l = (ph - 1) / 11, s = (ph - 1) % 11;
    switch (s) {
    case 0: run_stage<0>(P, l, lds); break;
    case 1: run_stage<1>(P, l, lds); break;
    case 2: run_stage<2>(P, l, lds); break;
    case 3: run_stage<3>(P, l, lds); break;
    case 4: run_stage<4>(P, l, lds); break;
    case 5: run_stage<5>(P, l, lds); break;
    case 6: run_stage<6>(P, l, lds); break;
    case 7: run_stage<7>(P, l, lds); break;
    case 8: run_stage<8>(P, l, lds); break;
    case 9: run_stage<9>(P, l, lds); break;
    default: run_stage<10>(P, l, lds); break;
    }
}

#if MK_SINGLE
__global__ void __launch_bounds__(512, 2) mega(Params P, int ph_lo, int ph_hi) {
    extern __shared__ __attribute__((aligned(16))) unsigned char shm[];
    LAS unsigned char* lds = (LAS unsigned char*)shm;
    cg::grid_group grid = cg::this_grid();
    volatile LAS unsigned* st = (volatile LAS unsigned*)(lds + LDS_ST);
    if (threadIdx.x == 0) { st[0] = 0u; st[1] = 0u; }
    __syncthreads();
    XcdBarrier xb; xb.bar = (unsigned*)(P.ws + WS_BAR); xb.x = xb_xcc_id(); xb.st = st;
    if (threadIdx.x == 0) {
        st[3] = xb_add(&xb.bar[XB_XCNT(xb.x)], 1u);
        st[2] = blockIdx.x;
    }
    __syncthreads();
    for (int ph = ph_lo; ph < ph_hi; ++ph) {
        if (ph_hi < 0) grid.sync();
        if (ph > ph_lo) xcd_barrier(xb);
        if (ph == ph_lo + 1) {
            if (threadIdx.x == 0) {
                bool ok = gridDim.x == 256u && xb.x < 8u;
                for (unsigned j = 0; j < 16; ++j) ok = ok && (xb_ld(&xb.bar[XB_XCNT(j)]) == (j < 8u ? 32u : 0u));
                if (ok) st[2] = xb.x + 8u * st[3];
            }
            __syncthreads();
        }
        run_phase(P, ph, lds);
    }
}
#else
template <int S> __global__ void __launch_bounds__(512, 2) stage_kernel(Params P, int l) {
    extern __shared__ __attribute__((aligned(16))) unsigned char shm[];
    if (threadIdx.x == 0) *(volatile LAS unsigned*)((LAS unsigned char*)shm + LDS_ST + 8) = blockIdx.x;
    __syncthreads();
    run_stage<S>(P, l, (LAS unsigned char*)shm);
}
template <int S> static void launch_stage(const Params& p, int l, int grid, hipStream_t stream) {
    static bool attr = false;
    if (!attr) { (void)hipFuncSetAttribute((const void*)stage_kernel<S>, hipFuncAttributeMaxDynamicSharedMemorySize, LDS_BYTES); attr = true; }
    hipLaunchKernelGGL(stage_kernel<S>, dim3(grid), dim3(512), LDS_BYTES, stream, p, l);
}
static void launch_phase(const Params& p, int ph, int grid, hipStream_t stream) {
    if (ph == 0) { launch_stage<11>(p, 0, grid, stream); return; }
    const int l = (ph - 1) / 11, s = (ph - 1) % 11;
    switch (s) {
    case 0: launch_stage<0>(p, l, grid, stream); break;
    case 1: launch_stage<1>(p, l, grid, stream); break;
    case 2: launch_stage<2>(p, l, grid, stream); break;
    case 3: launch_stage<3>(p, l, grid, stream); break;
    case 4: launch_stage<4>(p, l, grid, stream); break;
    case 5: launch_stage<5>(p, l, grid, stream); break;
    case 6: launch_stage<6>(p, l, grid, stream); break;
    case 7: launch_stage<7>(p, l, grid, stream); break;
    case 8: launch_stage<8>(p, l, grid, stream); break;
    case 9: launch_stage<9>(p, l, grid, stream); break;
    default: launch_stage<10>(p, l, grid, stream); break;
    }
}
#endif

extern "C" void kernel_launch(void* const* d_in, const int* in_sizes, int n_in, void* d_out, int out_size, void* d_ws, size_t ws_size, hipStream_t stream) {
    static int grid = 0;
    if (grid == 0) {
        if (n_in != 23 || ws_size < WS_END) { fprintf(stderr, "kernel_launch: unexpected n_in %d or ws_size %zu (< %zu)\n", n_in, ws_size, (size_t)WS_END); grid = -1; return; }
        int dev = 0, cus = 0;
        (void)hipGetDevice(&dev);
        (void)hipDeviceGetAttribute(&cus, hipDeviceAttributeMultiprocessorCount, dev);
#if MK_SINGLE
        int per_cu = 0;
        if (hipFuncSetAttribute((const void*)mega, hipFuncAttributeMaxDynamicSharedMemorySize, LDS_BYTES) != hipSuccess) { fprintf(stderr, "kernel_launch: hipFuncSetAttribute failed\n"); grid = -1; return; }
        if (hipOccupancyMaxActiveBlocksPerMultiprocessor(&per_cu, (const void*)mega, 512, LDS_BYTES) != hipSuccess || per_cu < 1) per_cu = 1;
        (void)hipGetLastError();
        grid = cus * per_cu;
#else
        grid = cus;
#endif
        if (grid > 256) grid = 256;
    }
    if (grid < 0) return;
    Params p{};
    const float** pp = (const float**)&p;
    for (int i = 0; i < 23; ++i) pp[i] = (const float*)d_in[i];
    p.out = (float*)d_out; p.ws = (unsigned char*)d_ws;
#if MK_SINGLE
    int lo = 0, hi = NPHASES;
    (void)hipMemsetAsync((unsigned char*)d_ws + WS_BAR, 0, 3456 * 4, stream);
    void* args[] = {&p, &lo, &hi};
    hipError_t e = hipLaunchCooperativeKernel((const void*)mega, dim3(grid), dim3(512), args, LDS_BYTES, stream);
    if (e != hipSuccess) fprintf(stderr, "cooperative launch failed: %s (grid %d)\n", hipGetErrorString(e), grid);
#else
#ifdef DBG_NPH
    for (int ph = 0; ph < DBG_NPH; ++ph) launch_phase(p, ph, grid, stream);
    launch_stage<12>(p, 0, grid, stream);
#else
    for (int ph = 0; ph < NPHASES; ++ph) {
#ifdef DUP_GROUP_END
        if (ph > 0 && (ph - 1) % 11 == 0) for (int q = 0; q <= DUP_GROUP_END; ++q) launch_phase(p, ph + q, grid, stream);
#endif
        launch_phase(p, ph, grid, stream);
#ifdef DUP_MASK
        if (ph > 0 && ((DUP_MASK >> ((ph - 1) % 11)) & 1)) launch_phase(p, ph, grid, stream);
#endif
    }
#endif
#endif
}
```

```cpp
#include <hip/hip_runtime.h>
#include <hip/hip_cooperative_groups.h>
#include <cstdio>
namespace cg = cooperative_groups;

#ifndef MK_SINGLE
#define MK_SINGLE 1
#endif

#define LAS __attribute__((address_space(3)))
#define GAS __attribute__((address_space(1)))
typedef unsigned short bf16_t;
typedef short bf16x8 __attribute__((ext_vector_type(8)));
typedef float f32x4 __attribute__((ext_vector_type(4)));
typedef unsigned u32x4 __attribute__((ext_vector_type(4)));
typedef unsigned u32x2 __attribute__((ext_vector_type(2)));

constexpr int DM = 1024, SEQ = 4096, RP = 8 * SEQ, RS = 16 * 32, R = RP + RS;
constexpr int INW = 7184, DFF = 4096;
constexpr int NCHH = (512 + 16) * 8;
constexpr size_t SLOT = (size_t)NCHH * 8192;
constexpr float ALPHA = 1.41421356237f;
constexpr size_t WIN_E = 0, WPOOL_E = 7168ull * 1024, WOUT_E = WPOOL_E + 1024ull * 256, WFF1_E = WOUT_E + 1024ull * 1024, WFF2_E = WFF1_E + 4096ull * 1024, WB_E = WFF2_E + 4096ull * 1024;
constexpr size_t WS_SLOT0 = WB_E * 2;
constexpr size_t WS_HALO = WS_SLOT0 + 7 * SLOT * 2;
constexpr size_t WS_AB = WS_HALO + 512ull * 3 * 3072 * 2;
constexpr size_t WS_GTOT = WS_AB + (size_t)R * 16 * 4;
constexpr size_t WS_BAR = WS_GTOT + (size_t)NCHH * 4;
constexpr size_t WS_PART = WS_BAR + 3456 * 4;
constexpr size_t WS_END = WS_PART + 3ull * RS * 1024 * 4;
constexpr size_t O_POOLP = (size_t)R * 1024, O_CONVP = O_POOLP + 2ull * 8 * 15 * 1024, O_DELTAP = O_CONVP + 2ull * 8 * 3 * 3072,
                 O_POOLS = O_DELTAP + 2ull * 8 * 8 * 16384, O_CONVS = O_POOLS + 2ull * 16 * 15 * 1024, O_DELTAS = O_CONVS + 2ull * 16 * 3 * 3072;
constexpr int LDS_ST = 139264;
constexpr int LDS_BYTES = LDS_ST + 16;

struct Params {
    const float *x_prompt, *x_sample, *state_pool, *state_conv, *state_delta, *ln_in_g, *ln_in_b, *w_in, *conv_w, *a_log, *dt_bias, *o_gain, *w_pool, *pool_scale,
        *w_out, *ln1_g, *ln1_b, *w_ff1, *b_ff1, *w_ff2, *b_ff2, *ln2_g, *ln2_b;
    float* out;
    unsigned char* ws;
};

__device__ __forceinline__ int opaque_tid() { int t = threadIdx.x; asm volatile("" : "+v"(t)); return t; }
__device__ __forceinline__ float bf2f(bf16_t b) { return __uint_as_float(((unsigned)b) << 16); }
__device__ __forceinline__ bf16_t f2bf(float f) { const __bf16 b = (__bf16)f; return __builtin_bit_cast(unsigned short, b); }
typedef float f32x2_t __attribute__((ext_vector_type(2)));
typedef __bf16 bf16x2_t __attribute__((ext_vector_type(2)));
__device__ __forceinline__ unsigned cvt_pk_bf16(float lo, float hi) { const f32x2_t v = {lo, hi}; const bf16x2_t b = __builtin_convertvector(v, bf16x2_t); return __builtin_bit_cast(unsigned, b); }
__device__ __forceinline__ u32x4 pack8(f32x4 a, f32x4 b) { u32x4 o; o[0] = cvt_pk_bf16(a[0], a[1]); o[1] = cvt_pk_bf16(a[2], a[3]); o[2] = cvt_pk_bf16(b[0], b[1]); o[3] = cvt_pk_bf16(b[2], b[3]); return o; }
__device__ __forceinline__ void unpack8(u32x4 v, float (&o)[8]) {
#pragma unroll
    for (int i = 0; i < 4; ++i) { o[2 * i] = __uint_as_float(v[i] << 16); o[2 * i + 1] = __uint_as_float(v[i] & 0xffff0000u); }
}
__device__ __forceinline__ float sigm(float x) { return __builtin_amdgcn_rcpf(1.f + __expf(-x)); }
__device__ __forceinline__ float silu(float x) { return x * __builtin_amdgcn_rcpf(1.f + __expf(-x)); }
__device__ __forceinline__ float softplus(float x) { const float e = __expf(-fabsf(x)); const float lp = (e < 1e-3f) ? e * (1.f - 0.5f * e) : __logf(1.f + e); return fmaxf(x, 0.f) + lp; }
__device__ __forceinline__ float wave_sum(float v) {
#pragma unroll
    for (int o = 1; o < 64; o <<= 1) v += __shfl_xor(v, o);
    return v;
}
__device__ __forceinline__ f32x4 mfma16(bf16x8 a, bf16x8 b, f32x4 c) { return __builtin_amdgcn_mfma_f32_16x16x32_bf16(a, b, c, 0, 0, 0); }
__device__ __forceinline__ bf16_t* slotp(const Params& P, int i) { return (bf16_t*)(P.ws + WS_SLOT0) + (size_t)i * SLOT; }
__device__ __forceinline__ bf16_t* wbf(const Params& P) { return (bf16_t*)P.ws; }


#define XB_TMO      128
#define XB_XCNT(j)  (256  + 64 * (j))
#define XB_XSUB(j)  (1280 + 64 * (j))
#define XB_XGEN(j)  (2304 + 64 * (j))
#define XB_TOP      3328
#define XB_TOPGEN   3392
#define XCD_BAR_WORDS 3456
#define XB_SPIN_CAP (1u << 18)
__device__ __forceinline__ unsigned xb_ld(unsigned* p)              { return __hip_atomic_load(p, __ATOMIC_RELAXED, __HIP_MEMORY_SCOPE_AGENT); }
__device__ __forceinline__ unsigned xb_add(unsigned* p, unsigned v) { return __hip_atomic_fetch_add(p, v, __ATOMIC_RELAXED, __HIP_MEMORY_SCOPE_AGENT); }
__device__ __forceinline__ unsigned xb_xcc_id() { return (unsigned)__builtin_amdgcn_s_getreg((3 << 11) | 20) & 0xFu; }
#define XB_SPIN(cond, bar) do { unsigned _sp = 0; while (cond) { __builtin_amdgcn_s_sleep(1); \
    if ((++_sp & 255u) == 0u) { if (xb_ld(&(bar)[XB_TMO])) break; if (_sp > XB_SPIN_CAP) { atomicAdd(&(bar)[XB_TMO], 1u); break; } } } } while (0)
struct XcdBarrier { unsigned* bar; unsigned x; volatile LAS unsigned* st; };
__device__ __forceinline__ XcdBarrier xcd_barrier_post(unsigned* bar, volatile LAS unsigned* st) {
    XcdBarrier b; b.bar = bar; b.x = xb_xcc_id(); b.st = st;
    if (threadIdx.x == 0) (void)xb_add(&bar[XB_XCNT(b.x)], 1u);
    return b;
}
__device__ __forceinline__ void xcd_barrier_complete(unsigned* bar, unsigned x, unsigned& nloc, unsigned& nx) {
    const unsigned G = gridDim.x * gridDim.y * gridDim.z;
    unsigned sum, cnt, mine, sp = 0u;
    for (;;) {
        sum = 0u; cnt = 0u; mine = 0u;
#pragma unroll
        for (unsigned j = 0; j < 16; ++j) { const unsigned c = xb_ld(&bar[XB_XCNT(j)]); sum += c; cnt += (c > 0u) ? 1u : 0u; mine = (j == x) ? c : mine; }
        if (sum == G) break;
        __builtin_amdgcn_s_sleep(1);
        if ((++sp & 255u) == 0u) { if (xb_ld(&bar[XB_TMO])) break; if (sp > XB_SPIN_CAP) { atomicAdd(&bar[XB_TMO], 1u); break; } }
    }
    nloc = mine > 0u ? mine : 1u; nx = cnt > 0u ? cnt : 1u;
}
__device__ __forceinline__ void xcd_barrier(const XcdBarrier& b) {
    asm volatile("s_waitcnt vmcnt(0)" ::: "memory");
    __syncthreads();
    if (threadIdx.x == 0) {
        unsigned* bar = b.bar;
        __builtin_amdgcn_s_waitcnt(0);
        unsigned nloc = b.st[0], nx = b.st[1];
        if (nloc == 0u) { xcd_barrier_complete(bar, b.x, nloc, nx); b.st[0] = nloc; b.st[1] = nx; }
        const unsigned old = xb_add(&bar[XB_XSUB(b.x)], 1u);
        const unsigned gen = old / nloc;
        if (old + 1u == (gen + 1u) * nloc) {
            __builtin_amdgcn_fence(__ATOMIC_RELEASE, "agent");
            asm volatile("s_waitcnt vmcnt(0)" ::: "memory");
            const unsigned og = xb_add(&bar[XB_TOP], 1u);
            const unsigned tg = og / nx;
            if (og + 1u == (tg + 1u) * nx) xb_add(&bar[XB_TOPGEN], 1u);
            else XB_SPIN(xb_ld(&bar[XB_TOPGEN]) == tg, bar);
            __builtin_amdgcn_fence(__ATOMIC_ACQUIRE, "agent");
            xb_add(&bar[XB_XGEN(b.x)], 1u);
            asm volatile("s_waitcnt vmcnt(0)" ::: "memory");
        } else {
            XB_SPIN(xb_ld(&bar[XB_XGEN(b.x)]) == gen, bar);
            __builtin_amdgcn_fence(__ATOMIC_ACQUIRE, "agent");
            asm volatile("s_waitcnt vmcnt(0)" ::: "memory");
        }
    }
    __syncthreads();
}

namespace pg8 {
constexpr int BM = 256, BK = 64, HALF = 128, HTB = HALF * BK * 2, NXCD = 8, WGM = 8;
__device__ __forceinline__ int lds_byte(int r, int c) { const int st = (r >> 4) * 2 + (c >> 5), rr = r & 15, cc = c & 31, ob = rr * 64 + cc * 2; return st * 1024 + (ob ^ (((ob >> 9) & 1) << 5)); }
__device__ __forceinline__ void stage_rc(int b, int& Rr, int& C) { const int st = b / 1024, sb = b % 1024, swz = sb ^ (((sb >> 9) & 1) << 5); Rr = (st >> 1) * 16 + swz / 64; C = (st & 1) * 32 + (swz % 64) / 2; }
__device__ __forceinline__ int perm32(int rho) { const int n = rho >> 4, i = rho & 15; return 8 * (i >> 2) + 4 * n + (i & 3); }
struct Unit { int pm, pn, ks; };
struct Gemm { const bf16_t* A; const bf16_t* Bt; int M, N, K, lda, apn, ldb, nks; };
struct StaticOrder {
    int nM, nN, nwg, G, c;
    int nNr;
    __device__ void init(int M, int N, int nks, int G_, int c_) { nM = M / BM; nNr = N / BM; nN = nNr * nks; nwg = nM * nN; G = G_; c = c_; }
    __device__ bool next(int i, Unit& u) const {
        const long L = (long)i * G + c; if (L >= nwg) return false;
        int wgid = (int)L; { const int q = nwg / NXCD, r = nwg % NXCD, xcd = wgid % NXCD, off = wgid / NXCD; wgid = (xcd < r ? xcd * (q + 1) : r * (q + 1) + (xcd - r) * q) + off; }
        const int nig = WGM * nN, gid = wgid / nig, fm = gid * WGM, gsz = (nM - fm) < WGM ? (nM - fm) : WGM;
        u.pm = fm + ((wgid % nig) % gsz); const int pq = (wgid % nig) / gsz; u.pn = pq % nNr; u.ks = pq / nNr; return true;
    }
};
template <class Epi>
__device__ __forceinline__ void gemm_phase(LAS unsigned char* lds, const Gemm g, const StaticOrder& S, const Epi& E) {
    const int tid = opaque_tid(), wid = __builtin_amdgcn_readfirstlane(tid >> 6), lane = tid & 63, wr = wid >> 2, wc = wid & 3, fr = lane & 15, fq = lane >> 4;
    int K_ = g.K; asm volatile("" : "+s"(K_));
    const int K = K_, nt = K / BK, lda = g.lda;
    unsigned voffA[2], voffB[2];
#pragma unroll
    for (int i = 0; i < 2; ++i) { int Rr, C; stage_rc(tid * 16 + i * 8192, Rr, C); const int Rb = Epi::PERM ? ((Rr & ~31) + perm32(Rr & 31)) : Rr;
        voffA[i] = (unsigned)(Rr * lda + C) * 2u; voffB[i] = (unsigned)(Rb * g.ldb + C) * 2u; }
    const size_t kstep = (size_t)(BK * 2);
    const size_t hstepA = (size_t)HALF * lda * 2, hstepB = (size_t)HALF * g.ldb * 2, sstep = (size_t)K * 2;
    const size_t tstepA = 2 * hstepA, tstepB = 2 * hstepB;
    const unsigned ldsw = (unsigned)wid * 1024u;
    const int aoff = lds_byte(wr * 64 + fr, fq * 8), boff = lds_byte(wc * 32 + fr, fq * 8);
#define PG8_SA(b, h) (((b) * 2 + (h)) * HTB)
#define PG8_SB(b, h) ((4 + (b) * 2 + (h)) * HTB)
#define PG8_STAGE(bufoff, gbase, voff) do { _Pragma("unroll") for (int _i = 0; _i < 2; ++_i) \
        __builtin_amdgcn_global_load_lds((const unsigned*)((const char*)(gbase) + (voff)[_i]), (LAS unsigned*)(lds + (bufoff) + ldsw + _i * 8192), 16, 0, 0); } while (0)
#define PG8_LDA(dst, b, h) do { _Pragma("unroll") for (int m = 0; m < 4; ++m) _Pragma("unroll") for (int k = 0; k < 2; ++k) dst[m][k] = *(const LAS bf16x8*)(lds + PG8_SA(b, h) + aoff + m * 2048 + k * 1024); } while (0)
#define PG8_LDB(dst, b, h) do { _Pragma("unroll") for (int n = 0; n < 2; ++n) _Pragma("unroll") for (int k = 0; k < 2; ++k) dst[n][k] = *(const LAS bf16x8*)(lds + PG8_SB(b, h) + boff + n * 2048 + k * 1024); } while (0)
#define PG8_MMA(ai, bj, At, Bt) do { __builtin_amdgcn_s_setprio(1); _Pragma("unroll") for (int m = 0; m < 4; ++m) _Pragma("unroll") for (int n = 0; n < 2; ++n) _Pragma("unroll") for (int k = 0; k < 2; ++k) \
        acc[ai][bj][m][n] = __builtin_amdgcn_mfma_f32_16x16x32_bf16(Bt[n][k], At[m][k], acc[ai][bj][m][n], 0, 0, 0); __builtin_amdgcn_s_setprio(0); } while (0)
#define PG8_WAIT_V(n) asm volatile("s_waitcnt vmcnt(" #n ")" ::: "memory")
#define PG8_WAIT_L(n) asm volatile("s_waitcnt lgkmcnt(" #n ")" ::: "memory")
#define PG8_BAR __builtin_amdgcn_s_barrier()
#define PG8_SCHED __builtin_amdgcn_sched_barrier(0)
    Unit cur, nxt; int ui = 0;
    if (!S.next(0, cur)) return;
    f32x4 acc[2][2][4][2];
#pragma unroll
    for (int a = 0; a < 2; ++a)
#pragma unroll
        for (int b = 0; b < 2; ++b)
#pragma unroll
            for (int m = 0; m < 4; ++m)
#pragma unroll
                for (int n = 0; n < 2; ++n) acc[a][b][m][n] = (f32x4){0.f, 0.f, 0.f, 0.f};
    bf16x8 At[4][2], B0[2][2], B1[2][2];
    const char* cA = (const char*)g.A + (size_t)cur.pm * tstepA + (size_t)cur.pn * g.apn * 2 + (size_t)cur.ks * sstep; const char* cB = (const char*)g.Bt + (size_t)cur.pn * tstepB + (size_t)cur.ks * sstep;
    PG8_STAGE(PG8_SB(0, 0), cB, voffB); PG8_STAGE(PG8_SB(0, 1), cB + hstepB, voffB); PG8_STAGE(PG8_SA(0, 0), cA, voffA); PG8_STAGE(PG8_SA(0, 1), cA + hstepA, voffA);
    if (wr == 1) PG8_BAR;
    PG8_WAIT_V(2); PG8_BAR;
    PG8_STAGE(PG8_SB(1, 0), cB + kstep, voffB); PG8_STAGE(PG8_SA(1, 0), cA + kstep, voffA); PG8_STAGE(PG8_SB(1, 1), cB + hstepB + kstep, voffB);
    PG8_WAIT_V(6); PG8_BAR;
    for (;;) {
        const bool has_next = S.next(ui + 1, nxt);
        const char* nA = has_next ? (const char*)g.A + (size_t)nxt.pm * tstepA + (size_t)nxt.pn * g.apn * 2 + (size_t)nxt.ks * sstep : cA; const char* nB = has_next ? (const char*)g.Bt + (size_t)nxt.pn * tstepB + (size_t)nxt.ks * sstep : cB;
        for (int t = 0; t < nt; t += 2) {
            const bool last = (t == nt - 2);
            const char* a1 = cA + (size_t)(t + 1) * kstep;
            const char* a2 = last ? nA : cA + (size_t)(t + 2) * kstep; const char* b2 = last ? nB : cB + (size_t)(t + 2) * kstep;
            const char* a3 = a2 + kstep; const char* b3 = b2 + kstep;
            PG8_LDB(B0, 0, 0); PG8_LDB(B1, 0, 1); PG8_SCHED; PG8_LDA(At, 0, 0); PG8_STAGE(PG8_SA(1, 1), a1 + hstepA, voffA);
            PG8_WAIT_V(8); PG8_WAIT_L(0); PG8_BAR; PG8_MMA(0, 0, At, B0); PG8_MMA(0, 1, At, B1); PG8_BAR; PG8_SCHED;
            PG8_LDA(At, 0, 1); PG8_STAGE(PG8_SB(0, 0), b2, voffB); PG8_STAGE(PG8_SB(0, 1), b2 + hstepB, voffB); PG8_STAGE(PG8_SA(0, 0), a2, voffA);
            PG8_WAIT_V(8); PG8_WAIT_L(0); PG8_BAR; PG8_MMA(1, 0, At, B0); PG8_MMA(1, 1, At, B1); PG8_BAR; PG8_SCHED;
            PG8_LDB(B0, 1, 0); PG8_LDB(B1, 1, 1); PG8_SCHED; PG8_LDA(At, 1, 0); PG8_STAGE(PG8_SA(0, 1), a2 + hstepA, voffA);
            PG8_WAIT_V(8); PG8_WAIT_L(0); PG8_BAR; PG8_MMA(0, 0, At, B0); PG8_MMA(0, 1, At, B1); PG8_BAR; PG8_SCHED;
            PG8_LDA(At, 1, 1); PG8_STAGE(PG8_SB(1, 0), b3, voffB); PG8_STAGE(PG8_SB(1, 1), b3 + hstepB, voffB); PG8_STAGE(PG8_SA(1, 0), a3, voffA);
            PG8_WAIT_V(8); PG8_WAIT_L(0); PG8_BAR; PG8_MMA(1, 0, At, B0); PG8_MMA(1, 1, At, B1); PG8_BAR; PG8_SCHED;
        }
        if (wr == 0) PG8_BAR;
        E(acc, cur, wr, wc, fr, fq);
        if (!has_next) break;
#pragma unroll
        for (int a = 0; a < 2; ++a)
#pragma unroll
            for (int b = 0; b < 2; ++b)
#pragma unroll
                for (int m = 0; m < 4; ++m)
#pragma unroll
                    for (int n = 0; n < 2; ++n) acc[a][b][m][n] = (f32x4){0.f, 0.f, 0.f, 0.f};
        cur = nxt; cA = nA; cB = nB; ++ui;
        if (wr == 1) PG8_BAR;
    }
    PG8_WAIT_V(0);
    PG8_BAR;
#undef PG8_SA
#undef PG8_SB
#undef PG8_STAGE
#undef PG8_LDA
#undef PG8_LDB
#undef PG8_MMA
#undef PG8_WAIT_V
#undef PG8_WAIT_L
#undef PG8_BAR
#undef PG8_SCHED
}
}
using pg8::Unit;
typedef f32x4 Acc[2][2][4][2];

struct EpiIn {
    static constexpr bool PERM = true;
    bf16_t *up, *q, *z, *ga; bf16_t* halo; float *pool_p, *conv_p, *pool_s, *conv_s;
    __device__ __forceinline__ void operator()(const Acc& acc, const Unit& u, int wr, int wc, int fr, int fq) const {
        const int t = u.pn >> 2;
        const int csb = (u.pn & 3) * 256 + wc * 32 + 8 * fq;
        const bool smp = u.pm >= 128;
        const bool lastp = !smp && (u.pm & 15) == 15;
#pragma unroll
        for (int ai = 0; ai < 2; ++ai)
#pragma unroll
            for (int m = 0; m < 4; ++m) {
                const int r = u.pm * 256 + ai * 128 + wr * 64 + m * 16 + fr;
                const int rs = r - RP;
#pragma unroll
                for (int bj = 0; bj < 2; ++bj) {
                    const int cs = csb + bj * 128;
                    const f32x4 v0 = acc[ai][bj][m][0], v1 = acc[ai][bj][m][1];
                    const u32x4 pk = pack8(v0, v1);
                    if (t == 0) {
                        *(u32x4*)(up + (size_t)r * 1024 + cs) = pk;
                        if (m == 3 && ai == 1 && lastp && wr == 1 && fr >= 1) {
                            float* so = pool_p + ((size_t)((r >> 12) * 15 + ((r & 4095) - 4081))) * 1024 + cs; *(f32x4*)so = v0; *(f32x4*)(so + 4) = v1; }
                        if ((m & 1) && smp && fr >= 1) {
                            float* so = pool_s + ((size_t)((rs >> 5) * 15 + ((rs & 31) - 17))) * 1024 + cs; *(f32x4*)so = v0; *(f32x4*)(so + 4) = v1; }
                    } else if (t <= 3) {
                        const int h = cs >> 7, c = cs & 127;
                        const size_t blk = smp ? ((size_t)((512 + (rs >> 5)) * 8 + h) * 64 + (rs & 31)) : ((size_t)((r >> 6) * 8 + h) * 64 + (r & 63));
                        *(u32x4*)(q + (size_t)(t - 1) * SLOT + blk * 128 + c) = pk;
                        const int cc = (t - 1) * 1024 + cs;
                        if (m == 3 && !smp && fr >= 13) {
                            const int chunk = r >> 6, i3 = (r & 63) - 61;
                            if ((chunk & 63) == 63) { float* so = conv_p + ((size_t)((r >> 12) * 3 + i3)) * 3072 + cc; *(f32x4*)so = v0; *(f32x4*)(so + 4) = v1; }
                            else *(u32x4*)(halo + ((size_t)(chunk + 1) * 3 + i3) * 3072 + cc) = pk;
                        }
                        if ((m & 1) && smp && fr >= 13) {
                            float* so = conv_s + ((size_t)((rs >> 5) * 3 + ((rs & 31) - 29))) * 3072 + cc; *(f32x4*)so = v0; *(f32x4*)(so + 4) = v1; }
                    } else if (t == 4) {
                        *(u32x4*)(z + (size_t)r * 1024 + cs) = pk;
                    } else {
                        *(u32x4*)(ga + (size_t)(t - 5) * R * 1024 + (size_t)r * 1024 + cs) = pk;
                    }
                }
            }
    }
};
struct EpiPool {
    static constexpr bool PERM = true;
    bf16_t* ga; const float* scale;
    __device__ __forceinline__ void operator()(const Acc& acc, const Unit& u, int wr, int wc, int fr, int fq) const {
        const int rb = u.pm * 256 + wr * 64 + fr, cb = u.pn * 256 + wc * 32 + 8 * fq;
        u32x4 gas[2][4];
        auto ldgrp = [&](int g, int slot) __attribute__((always_inline)) {
            const int c = cb + (g >> 1) * 128, ai = g & 1;
#pragma unroll
            for (int m = 0; m < 4; ++m) gas[slot][m] = *(const u32x4*)(ga + (size_t)(rb + ai * 128 + m * 16) * 1024 + c);
        };
        f32x4 sc[2][2];
#pragma unroll
        for (int bj = 0; bj < 2; ++bj) { sc[bj][0] = *(const f32x4*)(scale + cb + bj * 128); sc[bj][1] = *(const f32x4*)(scale + cb + bj * 128 + 4); }
        ldgrp(0, 0);
#pragma unroll
        for (int g = 0; g < 4; ++g) {
            const int slot = g & 1, bj = g >> 1, ai = g & 1;
            if (g + 1 < 4) ldgrp(g + 1, slot ^ 1);
            const int c = cb + bj * 128;
#pragma unroll
            for (int m = 0; m < 4; ++m) {
                float gv[8]; unpack8(gas[slot][m], gv);
                f32x4 v0 = acc[ai][bj][m][0], v1 = acc[ai][bj][m][1];
#pragma unroll
                for (int e = 0; e < 4; ++e) { v0[e] = sigm(gv[e]) * sc[bj][0][e] * v0[e]; v1[e] = sigm(gv[4 + e]) * sc[bj][1][e] * v1[e]; }
                *(u32x4*)(ga + (size_t)(rb + ai * 128 + m * 16) * 1024 + c) = pack8(v0, v1);
            }
        }
    }
};
struct EpiRes {
    static constexpr bool PERM = true;
    const bf16_t* res; const float* bias; bf16_t* out; float* part;
    __device__ __forceinline__ void operator()(const Acc& acc, const Unit& u, int wr, int wc, int fr, int fq) const {
        const int rb = u.pm * 256 + wr * 64 + fr, cb = u.pn * 256 + wc * 32 + 8 * fq;
        if (u.ks > 0) {
#pragma unroll
            for (int bj = 0; bj < 2; ++bj)
#pragma unroll
                for (int n = 0; n < 2; ++n)
#pragma unroll
                    for (int ai = 0; ai < 2; ++ai)
#pragma unroll
                        for (int m = 0; m < 4; ++m) *(f32x4*)(part + ((size_t)(u.ks - 1) * RS + rb + ai * 128 + m * 16) * 1024 + cb + bj * 128 + 4 * n) = acc[ai][bj][m][n];
            return;
        }
        u32x4 rv[2][4]; f32x4 bv[2][2];
#pragma unroll
        for (int bj = 0; bj < 2; ++bj)
#pragma unroll
            for (int n = 0; n < 2; ++n) bv[bj][n] = bias ? *(const f32x4*)(bias + cb + bj * 128 + 4 * n) : (f32x4){0.f, 0.f, 0.f, 0.f};
        auto ldgrp = [&](int g, int slot) __attribute__((always_inline)) {
            const int c = cb + (g >> 1) * 128, ai = g & 1;
#pragma unroll
            for (int m = 0; m < 4; ++m) rv[slot][m] = *(const u32x4*)(res + (size_t)(rb + ai * 128 + m * 16) * 1024 + c);
        };
        ldgrp(0, 0);
#pragma unroll
        for (int g = 0; g < 4; ++g) {
            const int slot = g & 1, bj = g >> 1, ai = g & 1;
            if (g + 1 < 4) ldgrp(g + 1, slot ^ 1);
            const int c = cb + bj * 128;
#pragma unroll
            for (int m = 0; m < 4; ++m) {
                float x[8]; unpack8(rv[slot][m], x);
                f32x4 o0 = acc[ai][bj][m][0] + bv[bj][0], o1 = acc[ai][bj][m][1] + bv[bj][1];
#pragma unroll
                for (int e = 0; e < 4; ++e) { o0[e] += ALPHA * x[e]; o1[e] += ALPHA * x[4 + e]; }
                *(u32x4*)(out + (size_t)(rb + ai * 128 + m * 16) * 1024 + c) = pack8(o0, o1);
            }
        }
    }
};
struct EpiFF1 {
    static constexpr bool PERM = true;
    bf16_t* h; const float* bias;
    __device__ __forceinline__ void operator()(const Acc& acc, const Unit& u, int wr, int wc, int fr, int fq) const {
        f32x4 bb[2][2];
#pragma unroll
        for (int bj = 0; bj < 2; ++bj) { const int c = u.pn * 256 + bj * 128 + wc * 32 + 8 * fq; bb[bj][0] = *(const f32x4*)(bias + c); bb[bj][1] = *(const f32x4*)(bias + c + 4); }
#pragma unroll
        for (int bj = 0; bj < 2; ++bj) {
            const int c = u.pn * 256 + bj * 128 + wc * 32 + 8 * fq;
            const f32x4 b0 = bb[bj][0], b1 = bb[bj][1];
#pragma unroll
            for (int ai = 0; ai < 2; ++ai)
#pragma unroll
                for (int m = 0; m < 4; ++m) {
                    const int r = u.pm * 256 + ai * 128 + wr * 64 + m * 16 + fr;
                    f32x4 v0 = acc[ai][bj][m][0] + b0, v1 = acc[ai][bj][m][1] + b1;
#pragma unroll
                    for (int e = 0; e < 4; ++e) { const float a = fmaxf(v0[e], 0.f), b = fmaxf(v1[e], 0.f); v0[e] = a * a; v1[e] = b * b; }
                    *(u32x4*)(h + (size_t)r * DFF + c) = pack8(v0, v1);
                }
        }
    }
};
template <class Epi> __device__ __forceinline__ void run_gemm(LAS unsigned char* lds, const bf16_t* A, int lda, int apn, const bf16_t* Bt, int M, int N, int K, const Epi& E, int nks = 1) {
    pg8::Gemm g; g.A = A; g.Bt = Bt; g.M = M; g.N = N; g.K = K / nks; g.lda = lda; g.apn = apn; g.ldb = K; g.nks = nks;
    pg8::StaticOrder S; S.init(M, N, nks, (int)gridDim.x, (int)*(volatile LAS unsigned*)(lds + LDS_ST + 8));
    pg8::gemm_phase<Epi>(lds, g, S, E);
}

struct TileRef { const float* src; bf16_t* dst; int ld_src, ld_dst; };
__device__ __forceinline__ TileRef weight_tile(const Params& P, int l, int it) {
    bf16_t* wb = wbf(P); TileRef t; int kb, nb;
    if (it < 1792) { kb = it / 112; nb = it % 112; t.src = P.w_in + (size_t)l * 1024 * INW; t.ld_src = INW; t.dst = wb + WIN_E; t.ld_dst = 1024; }
    else if (it < 1856) { const int j = it - 1792, g = j >> 4; kb = (j >> 2) & 3; nb = j & 3; t.src = P.w_pool + ((size_t)l * 4 + g) * 65536; t.ld_src = 256; t.dst = wb + WPOOL_E + (size_t)g * 65536; t.ld_dst = 256; }
    else if (it < 2112) { const int j = it - 1856; kb = j >> 4; nb = j & 15; t.src = P.w_out + (size_t)l * 1048576; t.ld_src = 1024; t.dst = wb + WOUT_E; t.ld_dst = 1024; }
    else if (it < 3136) { const int j = it - 2112; kb = j >> 6; nb = j & 63; t.src = P.w_ff1 + (size_t)l * 4194304; t.ld_src = 4096; t.dst = wb + WFF1_E; t.ld_dst = 1024; }
    else { const int j = it - 3136; kb = j >> 4; nb = j & 15; t.src = P.w_ff2 + (size_t)l * 4194304; t.ld_src = 1024; t.dst = wb + WFF2_E; t.ld_dst = 4096; }
    t.src += (size_t)(kb * 64) * t.ld_src + nb * 64; t.dst += (size_t)(nb * 64) * t.ld_dst + kb * 64;
    return t;
}
__device__ __forceinline__ void convert_weights(const Params& P, int l, LAS unsigned char* lds) {
    LAS float* t = (LAS float*)lds;
    const int tid = opaque_tid();
    const int kk0 = tid >> 4, n4 = (tid & 15) * 4, G = (int)gridDim.x;
    f32x4 preA[2], preB[2], preC[2];
    auto ldt = [&](int it, f32x4 (&pre)[2]) __attribute__((always_inline)) {
        if (it < 4160) { const TileRef T = weight_tile(P, l, it);
#pragma unroll
            for (int p = 0; p < 2; ++p) pre[p] = *(const f32x4*)(T.src + (size_t)(kk0 + 32 * p) * T.ld_src + n4); }
    };
    auto doit = [&](int it, const f32x4 (&pre)[2]) __attribute__((always_inline)) {
        const TileRef T = weight_tile(P, l, it);
#pragma unroll
        for (int p = 0; p < 2; ++p) { const int kk = kk0 + 32 * p; t[kk * 65 + n4] = pre[p][0]; t[kk * 65 + n4 + 1] = pre[p][1]; t[kk * 65 + n4 + 2] = pre[p][2]; t[kk * 65 + n4 + 3] = pre[p][3]; }
        __syncthreads();
        { const int n = tid >> 3, k8 = (tid & 7) * 8; u32x4 o;
#pragma unroll
          for (int e = 0; e < 4; ++e) o[e] = cvt_pk_bf16(t[(k8 + 2 * e) * 65 + n], t[(k8 + 2 * e + 1) * 65 + n]);
          *(u32x4*)(T.dst + (size_t)n * T.ld_dst + k8) = o; }
        __syncthreads();
    };
    int it = blockIdx.x;
    ldt(it, preA); ldt(it + G, preB); ldt(it + 2 * G, preC);
    while (it < 4160) {
        doit(it, preA); ldt(it + 3 * G, preA); it += G; if (it >= 4160) break;
        doit(it, preB); ldt(it + 3 * G, preB); it += G; if (it >= 4160) break;
        doit(it, preC); ldt(it + 3 * G, preC); it += G;
    }
}

template <int N> __device__ __forceinline__ float reduce_scatter(float (&v)[N], int lane);
__device__ __forceinline__ int bitrev(int x, int bits);
__device__ __forceinline__ void ln_phase(const Params& P, const float* src0, const float* src1, const float* g, const float* b, bf16_t* xb, float* yf, int wl, LAS unsigned char* lds, const float* part = nullptr, const bf16_t* srcb = nullptr) {
    LAS float* wt = (LAS float*)lds;
    const int tid = opaque_tid(), lane = tid & 63, wid = tid >> 6;
    if (wl >= 0) {
        const float* w16 = P.w_in + (size_t)wl * 1024 * INW + 7168;
        for (int i = tid; i < 1024 * 4; i += 512) { const int k = i >> 2, j4 = (i & 3) * 4; const f32x4 v = *(const f32x4*)(w16 + (size_t)k * INW + j4);
            const int kk = ((k >> 8) * 4 + (k & 3)) * 64 + ((k >> 2) & 63); *(LAS f32x4*)(wt + kk * 16 + j4) = v; }
        __syncthreads();
    }
    f32x4 gv[4], bv[4];
#pragma unroll
    for (int j = 0; j < 4; ++j) { gv[j] = *(const f32x4*)(g + lane * 4 + 256 * j); bv[j] = *(const f32x4*)(b + lane * 4 + 256 * j); }
    float* ab = (float*)(P.ws + WS_AB);
    const int rstride = gridDim.x * 8;
    f32x4 vn[4], vn2[4];
    auto ldrow = [&](int rr, f32x4 (&d)[4]) __attribute__((always_inline)) {
        if (rr < R) {
            if (srcb) {
#pragma unroll
                for (int j = 0; j < 4; ++j) { const u32x2 t = *(const u32x2*)(srcb + (size_t)rr * 1024 + lane * 4 + 256 * j);
                    d[j][0] = __uint_as_float(t[0] << 16); d[j][1] = __uint_as_float(t[0] & 0xffff0000u); d[j][2] = __uint_as_float(t[1] << 16); d[j][3] = __uint_as_float(t[1] & 0xffff0000u); }
            } else { const float* xr = (rr < RP) ? src0 + (size_t)rr * 1024 : src1 + (size_t)(rr - RP) * 1024;
#pragma unroll
                for (int j = 0; j < 4; ++j) d[j] = *(const f32x4*)(xr + lane * 4 + 256 * j); }
        }
    };
    ldrow(blockIdx.x * 8 + wid, vn); ldrow(blockIdx.x * 8 + wid + rstride, vn2);
    f32x4 vp[4]; int rp = 0; bool have_prev = false;
    for (int r = blockIdx.x * 8 + wid; r < R; r += rstride) {
        f32x4 v[4]; float s = 0.f;
#pragma unroll
        for (int j = 0; j < 4; ++j) { v[j] = vn[j]; vn[j] = vn2[j]; }
        ldrow(r + 2 * rstride, vn2);
        if (part && r >= RP) {
#pragma unroll
            for (int q = 0; q < 3; ++q)
#pragma unroll
                for (int j = 0; j < 4; ++j) v[j] = v[j] + *(const f32x4*)(part + ((size_t)q * RS + (r - RP)) * 1024 + lane * 4 + 256 * j);
        }
#pragma unroll
        for (int j = 0; j < 4; ++j) s += (v[j][0] + v[j][1]) + (v[j][2] + v[j][3]);
        const float mean = wave_sum(s) * (1.f / 1024.f); float s2 = 0.f;
#pragma unroll
        for (int j = 0; j < 4; ++j) { v[j] = v[j] - mean; s2 += (v[j][0] * v[j][0] + v[j][1] * v[j][1]) + (v[j][2] * v[j][2] + v[j][3] * v[j][3]); }
        const float rstd = rsqrtf(wave_sum(s2) * (1.f / 1024.f) + 1e-5f);
#pragma unroll
        for (int j = 0; j < 4; ++j) v[j] = v[j] * rstd * gv[j] + bv[j];
        if (xb) {
#pragma unroll
            for (int j = 0; j < 4; ++j) { u32x2 o; o[0] = cvt_pk_bf16(v[j][0], v[j][1]); o[1] = cvt_pk_bf16(v[j][2], v[j][3]); *(u32x2*)(xb + (size_t)r * 1024 + lane * 4 + 256 * j) = o; }
        }
        if (yf) {
#pragma unroll
            for (int j = 0; j < 4; ++j) *(f32x4*)(yf + (size_t)r * 1024 + lane * 4 + 256 * j) = v[j];
        }
        if (wl >= 0) {
            if (!have_prev) {
#pragma unroll
                for (int j = 0; j < 4; ++j) vp[j] = v[j];
                rp = r; have_prev = true;
            } else {
                float p0[16], p1[16];
#pragma unroll
                for (int q = 0; q < 16; ++q) { p0[q] = 0.f; p1[q] = 0.f; }
#pragma unroll
                for (int j = 0; j < 4; ++j)
#pragma unroll
                    for (int e = 0; e < 4; ++e) {
                        const LAS f32x4* wp = (const LAS f32x4*)(wt + ((j * 4 + e) * 64 + lane) * 16);
                        const float x0 = vp[j][e], x1 = v[j][e];
#pragma unroll
                        for (int q4 = 0; q4 < 4; ++q4) { const f32x4 w = wp[q4];
                            p0[q4 * 4] += x0 * w[0]; p0[q4 * 4 + 1] += x0 * w[1]; p0[q4 * 4 + 2] += x0 * w[2]; p0[q4 * 4 + 3] += x0 * w[3];
                            p1[q4 * 4] += x1 * w[0]; p1[q4 * 4 + 1] += x1 * w[1]; p1[q4 * 4 + 2] += x1 * w[2]; p1[q4 * 4 + 3] += x1 * w[3]; }
                        if (e == 3) __builtin_amdgcn_sched_barrier(0);
                    }
                float o0 = reduce_scatter<16>(p0, lane), o1 = reduce_scatter<16>(p1, lane);
                o0 += __shfl_xor(o0, 16); o1 += __shfl_xor(o1, 16); o0 += __shfl_xor(o0, 32); o1 += __shfl_xor(o1, 32);
                if (lane < 16) { ab[(size_t)rp * 16 + bitrev(lane, 4)] = o0; ab[(size_t)r * 16 + bitrev(lane, 4)] = o1; }
                have_prev = false;
            }
        }
    }
    if (wl >= 0 && have_prev) {
        float p[16];
#pragma unroll
        for (int q = 0; q < 16; ++q) p[q] = 0.f;
#pragma unroll
        for (int j = 0; j < 4; ++j)
#pragma unroll
            for (int e = 0; e < 4; ++e) {
                const LAS f32x4* wp = (const LAS f32x4*)(wt + ((j * 4 + e) * 64 + lane) * 16);
                const float xv = vp[j][e];
#pragma unroll
                for (int q4 = 0; q4 < 4; ++q4) { const f32x4 w = wp[q4]; p[q4 * 4] += xv * w[0]; p[q4 * 4 + 1] += xv * w[1]; p[q4 * 4 + 2] += xv * w[2]; p[q4 * 4 + 3] += xv * w[3]; }
                if (e == 3) __builtin_amdgcn_sched_barrier(0);
            }
        float ov = reduce_scatter<16>(p, lane);
        ov += __shfl_xor(ov, 16); ov += __shfl_xor(ov, 32);
        if (lane < 16) ab[(size_t)rp * 16 + bitrev(lane, 4)] = ov;
    }
}

__device__ __forceinline__ void mixed_phase(const Params& P, int l) {
    const bf16_t* up = slotp(P, 1); bf16_t* mx = slotp(P, 6);
    const int nitems = (1024 + 16) * 128;
    for (int idx = blockIdx.x * 512 + opaque_tid(); idx < nitems; idx += gridDim.x * 512) {
        const int blk = idx >> 7, c = (idx & 127) * 8;
        int rbase, t0, sb; bool smp;
        if (blk < 1024) { rbase = (blk >> 7) * 4096; t0 = (blk & 127) * 32; smp = false; sb = 0; }
        else { sb = blk - 1024; rbase = RP + sb * 32; t0 = 0; smp = true; }
        const int w = 2 << (c >> 8);
        const float* hist = P.state_pool + ((size_t)(l * 16 + sb) * 15) * 1024 + c;
        auto ldu = [&](int t, float (&o)[8]) __attribute__((always_inline)) {
            if (t >= 0) { unpack8(*(const u32x4*)(up + (size_t)(rbase + t) * 1024 + c), o); }
            else if (smp) { const f32x4 a = *(const f32x4*)(hist + (size_t)(15 + t) * 1024), b2 = *(const f32x4*)(hist + (size_t)(15 + t) * 1024 + 4);
#pragma unroll
                for (int e = 0; e < 4; ++e) { o[e] = a[e]; o[4 + e] = b2[e]; } }
            else {
#pragma unroll
                for (int e = 0; e < 8; ++e) o[e] = 0.f; }
        };
        float s[8];
#pragma unroll
        for (int e = 0; e < 8; ++e) s[e] = 0.f;
        for (int d0 = 1; d0 < w; d0 += 4) {
            float hb[4][8];
#pragma unroll
            for (int q = 0; q < 4; ++q) { if (d0 + q < w) ldu(t0 - d0 - q, hb[q]); else {
#pragma unroll
                for (int e = 0; e < 8; ++e) hb[q][e] = 0.f; } }
#pragma unroll
            for (int q = 0; q < 4; ++q)
#pragma unroll
                for (int e = 0; e < 8; ++e) s[e] += hb[q][e];
        }
        float cur[4][8], old[4][8], ncur[4][8], nold[4][8];
#pragma unroll
        for (int q = 0; q < 4; ++q) { ldu(t0 + q, cur[q]); ldu(t0 + q - w + 1, old[q]); }
#pragma unroll
        for (int i0 = 0; i0 < 32; i0 += 4) {
            if (i0 + 4 < 32) {
#pragma unroll
                for (int q = 0; q < 4; ++q) { ldu(t0 + i0 + 4 + q, ncur[q]); ldu(t0 + i0 + 4 + q - w + 1, nold[q]); }
            }
#pragma unroll
            for (int q = 0; q < 4; ++q) {
                const int i = i0 + q;
                const float inv = 1.f / (smp ? (float)w : (float)min(w, t0 + i + 1));
                f32x4 o0, o1;
#pragma unroll
                for (int e = 0; e < 8; ++e) s[e] += cur[q][e];
#pragma unroll
                for (int e = 0; e < 4; ++e) { o0[e] = s[e] * inv - cur[q][e]; o1[e] = s[4 + e] * inv - cur[q][4 + e]; }
                *(u32x4*)(mx + (size_t)(rbase + t0 + i) * 1024 + c) = pack8(o0, o1);
#pragma unroll
                for (int e = 0; e < 8; ++e) s[e] -= old[q][e];
            }
#pragma unroll
            for (int q = 0; q < 4; ++q)
#pragma unroll
                for (int e = 0; e < 8; ++e) { cur[q][e] = ncur[q][e]; old[q][e] = nold[q][e]; }
        }
    }
}

template <int N> __device__ __forceinline__ float reduce_scatter(float (&v)[N], int lane) {
    int n = N;
#pragma unroll
    for (int s = 0; (1 << s) < N; ++s) {
        const unsigned mk = ((lane >> s) & 1) ? 0xffffffffu : 0u; const int hn = n >> 1;
#pragma unroll
        for (int j = 0; j < (N >> (s + 1)); ++j) { const unsigned ua = __float_as_uint(v[j]), ub = __float_as_uint(v[j + hn]);
            const float send = __uint_as_float((ua & mk) | (ub & ~mk)); const float keep = __uint_as_float((ub & mk) | (ua & ~mk)); v[j] = keep + __shfl_xor(send, 1 << s); }
        n = hn;
    }
    return v[0];
}
__device__ __forceinline__ int bitrev(int x, int bits) { int r = 0; for (int i = 0; i < bits; ++i) r |= ((x >> i) & 1) << (bits - 1 - i); return r; }

#define P2_BAR() asm volatile("s_waitcnt lgkmcnt(0)\n\ts_barrier" ::: "memory")
__device__ __forceinline__ void delta_pre_phase(const Params& P, int l, LAS unsigned char* lds0) {
    const int tid = opaque_tid(), half = tid >> 8, th0 = tid & 255;
    LAS unsigned char* lds = lds0 + half * 65536;
    LAS float* Lf = (LAS float*)lds;
    LAS bf16_t* kb = (LAS bf16_t*)(lds + 16384);
    LAS bf16_t* qb = (LAS bf16_t*)(lds + 33792);
    LAS float* gc = (LAS float*)(lds + 55296);
    LAS float* be = gc + 64; LAS float* eg = gc + 128; LAS float* rnk = gc + 192; LAS float* rnq = gc + 256;
    LAS float* red = gc + 320;
    const bf16_t* halo = (const bf16_t*)(P.ws + WS_HALO);
    const float* ab = (const float*)(P.ws + WS_AB);
    float* gtot = (float*)(P.ws + WS_GTOT);
    bf16_t* qs = slotp(P, 2); bf16_t* ks = slotp(P, 3); bf16_t* vs = slotp(P, 4); bf16_t* ws_ = slotp(P, 1); bf16_t* ats = slotp(P, 6);
    const float* cw = P.conv_w + (size_t)l * 4 * 3072;
    for (int pair = blockIdx.x; pair < NCHH / 2; pair += gridDim.x) {
        int th = th0; asm volatile("" : "+v"(th));
        const int wv4 = th >> 6, lane = th & 63;
        const int ch = pair * 2 + half;
        const bool smp = ch >= 4096;
        const int chunk = ch >> 3, h = ch & 7, sb = smp ? chunk - 512 : 0, n = chunk & 63;
        const int r0 = smp ? RP + sb * 32 : chunk * 64, nvalid = smp ? 32 : 64;
        bf16_t* qblk = qs + (size_t)ch * 8192; bf16_t* kblk = ks + (size_t)ch * 8192; bf16_t* vblk = vs + (size_t)ch * 8192;
        if (wv4 == 0) {
            const bool valid = lane < nvalid; const int r = r0 + (valid ? lane : 0);
            const float braw = ab[(size_t)r * 16 + h], araw = ab[(size_t)r * 16 + 8 + h];
            const float beta = valid ? sigm(braw) : 0.f;
            float gg = valid ? -__expf(P.a_log[l * 8 + h]) * softplus(araw + P.dt_bias[l * 8 + h]) : 0.f;
#pragma unroll
            for (int d = 1; d < 64; d <<= 1) { const float o = __shfl_up(gg, d); if (lane >= d) gg += o; }
            gc[lane] = gg; be[lane] = beta; eg[lane] = __expf(gg); rnk[lane] = __expf(__shfl(gg, 63) - gg);
            if (lane == 63) gtot[ch] = __expf(gg);
        }
        const int col = th & 127;
        const float* sconv = P.state_conv + (size_t)(l * 16 + sb) * 3 * 3072;
        auto halo_val = [&](int sec, int hi) __attribute__((always_inline)) -> float {
            const int cc = sec * 1024 + h * 128 + col;
            if (smp) return sconv[(size_t)hi * 3072 + cc];
            if (n == 0) return 0.f;
            return bf2f(halo[((size_t)chunk * 3 + hi) * 3072 + cc]);
        };
        const int rh = th >> 7;
        LAS float* rk = gc + 256; LAS float* rq = gc + 320;
        float qx[32], x[64];
        {
            const int ccq = h * 128 + col, sec = (th < 128) ? 1 : 2, cck = sec * 1024 + h * 128 + col;
            const float qw0 = cw[ccq], qw1 = cw[3072 + ccq], qw2 = cw[2 * 3072 + ccq], qw3 = cw[3 * 3072 + ccq];
            const float kw0 = cw[cck], kw1 = cw[3072 + cck], kw2 = cw[2 * 3072 + cck], kw3 = cw[3 * 3072 + cck];
            float qm3, qm2, qm1;
            if (rh == 0) { qm3 = halo_val(0, 0); qm2 = halo_val(0, 1); qm1 = halo_val(0, 2); }
            else { qm3 = bf2f(qblk[29 * 128 + col]); qm2 = bf2f(qblk[30 * 128 + col]); qm1 = bf2f(qblk[31 * 128 + col]); }
            float km3 = halo_val(sec, 0), km2 = halo_val(sec, 1), km1 = halo_val(sec, 2);
            const GAS bf16_t* pq = (const GAS bf16_t*)(qblk + (rh * 32) * 128 + col);
            const GAS bf16_t* pk = (const GAS bf16_t*)((th < 128 ? kblk : vblk) + col);
#pragma unroll
            for (int i = 0; i < 32; ++i) qx[i] = bf2f(pq[i * 128]);
#pragma unroll
            for (int i = 0; i < 64; ++i) x[i] = bf2f(pk[i * 128]);
            if (smp) {
                const int nv = nvalid - rh * 32;
#pragma unroll
                for (int i = 0; i < 32; ++i) qx[i] = (i < nv) ? qx[i] : 0.f;
#pragma unroll
                for (int i = 0; i < 64; ++i) x[i] = (i < nvalid) ? x[i] : 0.f;
            }
#pragma unroll
            for (int i = 0; i < 32; ++i) { const float x0 = qx[i];
                const float y = qw0 * qm3 + qw1 * qm2 + qw2 * qm1 + qw3 * x0; const float sv = silu(y); qx[i] = sv; qb[(rh * 32 + i) * 136 + col] = f2bf(sv); qm3 = qm2; qm2 = qm1; qm1 = x0; }
#pragma unroll
            for (int i = 0; i < 64; ++i) { const float x0 = x[i];
                const float y = kw0 * km3 + kw1 * km2 + kw2 * km1 + kw3 * x0; x[i] = silu(y); km3 = km2; km2 = km1; km1 = x0; }
        }
        if (th < 128) {
#pragma unroll
            for (int i = 0; i < 64; ++i) kb[i * 136 + col] = f2bf(x[i]);
        }
        P2_BAR();
        const int m = wv4, ln = lane & 15, lq = lane >> 4;
        f32x4 aL[4], aA[4];
        {
            f32x4 aQ = (f32x4){0.f, 0.f, 0.f, 0.f};
            bf16x8 ak[4], aq[4];
#pragma unroll
            for (int ksx = 0; ksx < 4; ++ksx) { const int ko = 32 * ksx + lq * 8;
                ak[ksx] = *(const LAS bf16x8*)(kb + (16 * m + ln) * 136 + ko); aq[ksx] = *(const LAS bf16x8*)(qb + (16 * m + ln) * 136 + ko); }
#pragma unroll
            for (int ksx = 0; ksx < 4; ++ksx) aQ = mfma16(aq[ksx], aq[ksx], aQ);
#pragma unroll
            for (int nn = 0; nn < 4; ++nn) {
                aL[nn] = (f32x4){0.f, 0.f, 0.f, 0.f}; aA[nn] = (f32x4){0.f, 0.f, 0.f, 0.f};
                if (nn <= m) {
#pragma unroll
                    for (int ksx = 0; ksx < 4; ++ksx) {
                        const bf16x8 bk = *(const LAS bf16x8*)(kb + (16 * nn + ln) * 136 + 32 * ksx + lq * 8);
                        aL[nn] = mfma16(ak[ksx], bk, aL[nn]); aA[nn] = mfma16(bk, aq[ksx], aA[nn]);
                    }
                }
                if (nn == m && (ln >> 2) == lq) {
                    const int rg = ln & 3;
                    const float gk = rg == 0 ? aL[nn][0] : rg == 1 ? aL[nn][1] : rg == 2 ? aL[nn][2] : aL[nn][3];
                    const float gq = rg == 0 ? aQ[0] : rg == 1 ? aQ[1] : rg == 2 ? aQ[2] : aQ[3];
                    rk[16 * m + ln] = rsqrtf(gk + 1e-6f); rq[16 * m + ln] = rsqrtf(gq + 1e-6f) * 0.08838834764831845f;
                }
            }
        }
        P2_BAR();
        {
            bf16_t* at = ats + (size_t)ch * 4096;
#pragma unroll
            for (int nn = 0; nn < 4; ++nn) {
                const int j = 16 * nn + ln; const float gj = gc[j], rkj = rk[j];
#pragma unroll
                for (int rg = 0; rg < 4; ++rg) {
                    const int i = 16 * m + lq * 4 + rg;
                    const float d = (i >= j) ? __expf(gc[i] - gj) * rkj : 0.f;
                    Lf[i * 64 + (j & 3) * 16 + (j >> 2)] = (i > j) ? be[i] * rk[i] * aL[nn][rg] * d : 0.f;
                }
                {
                    const int i2 = 16 * m + ln, j2 = 16 * nn + 4 * lq; const float gi = gc[i2], rqi = rq[i2];
                    float av[4];
#pragma unroll
                    for (int rg = 0; rg < 4; ++rg) av[rg] = (i2 >= j2 + rg) ? rqi * aA[nn][rg] * __expf(gi - gc[j2 + rg]) * rk[j2 + rg] : 0.f;
                    u32x2 o; o[0] = cvt_pk_bf16(av[0], av[1]); o[1] = cvt_pk_bf16(av[2], av[3]);
                    *(u32x2*)(at + i2 * 64 + j2) = o;
                }
            }
        }
        if (th < 128) {
            u32x4 o[8];
#pragma unroll
            for (int i = 0; i < 64; i += 2) {
                const float k0 = x[i] * rk[i], k1 = x[i + 1] * rk[i + 1];
                o[i >> 3][(i >> 1) & 3] = cvt_pk_bf16(k0 * rnk[i], k1 * rnk[i + 1]);
                x[i] = k0 * be[i] * eg[i]; x[i + 1] = k1 * be[i + 1] * eg[i + 1];
            }
#pragma unroll
            for (int e = 0; e < 8; ++e) *(u32x4*)(kblk + col * 64 + e * 8) = o[e];
        } else {
#pragma unroll
            for (int i = 0; i < 64; ++i) x[i] *= be[i];
        }
        {
#pragma unroll
            for (int e = 0; e < 4; ++e) {
                const int pc = th + 256 * e, row = pc >> 4, c8 = (pc & 15) * 8;
                float qv[8]; unpack8(*(const LAS u32x4*)(qb + row * 136 + c8), qv);
                const float sc = rq[row] * eg[row];
                f32x4 o0, o1;
#pragma unroll
                for (int q = 0; q < 4; ++q) { o0[q] = qv[q] * sc; o1[q] = qv[4 + q] * sc; }
                *(u32x4*)(qblk + row * 128 + c8) = pack8(o0, o1);
            }
        }
        P2_BAR();
        LAS bf16_t* Thi = (LAS bf16_t*)(lds + 36864);
        {
            const int c = th >> 2, t4 = th & 3;
            float z[16];
#pragma unroll
            for (int q = 0; q < 16; ++q) z[q] = 0.f;
#pragma unroll
            for (int i = 0; i < 64; ++i) {
                float p = 0.f;
#pragma unroll
                for (int q4 = 0; q4 < (i + 15) / 16; ++q4) {
                    const f32x4 lv = *(const LAS f32x4*)(Lf + i * 64 + t4 * 16 + q4 * 4);
                    p += lv[0] * z[q4 * 4]; p += lv[1] * z[q4 * 4 + 1]; p += lv[2] * z[q4 * 4 + 2]; p += lv[3] * z[q4 * 4 + 3];
                }
                p += __builtin_bit_cast(float, __builtin_amdgcn_update_dpp(0, __builtin_bit_cast(int, p), 0xB1, 0xF, 0xF, true));
                p += __builtin_bit_cast(float, __builtin_amdgcn_update_dpp(0, __builtin_bit_cast(int, p), 0x4E, 0xF, 0xF, true));
                const float y = ((i == c) ? 1.f : 0.f) - p;
                const bool mine = t4 == (i & 3);
                z[i >> 2] = mine ? y : z[i >> 2];
                if (mine) Thi[i * 72 + c] = f2bf(y);
                if ((i & 3) == 3) __builtin_amdgcn_sched_barrier(0);
            }
        }
        P2_BAR();
        {
            LAS unsigned char* rT = lds;
#pragma unroll
            for (int e = 0; e < 8; ++e) { u32x4 o;
#pragma unroll
                for (int q = 0; q < 4; ++q) o[q] = cvt_pk_bf16(x[e * 8 + 2 * q], x[e * 8 + 2 * q + 1]);
                *(LAS u32x4*)(rT + th * 144 + e * 16) = o; }
        }
        P2_BAR();
        {
            LAS unsigned char* rT = lds;
            bf16_t* wblk = ws_ + (size_t)ch * 8192;
            bf16x8 th_[2];
#pragma unroll
            for (int ksx = 0; ksx < 2; ++ksx) th_[ksx] = *(const LAS bf16x8*)(Thi + (16 * wv4 + ln) * 72 + 32 * ksx + 8 * lq);
#pragma unroll
            for (int nt8 = 0; nt8 < 8; ++nt8) {
                f32x4 acc = (f32x4){0.f, 0.f, 0.f, 0.f};
#pragma unroll
                for (int ksx = 0; ksx < 2; ++ksx) {
                    const bf16x8 bv = *(const LAS bf16x8*)(rT + (128 + 16 * nt8 + ln) * 144 + (32 * ksx + 8 * lq) * 2);
                    acc = mfma16(th_[ksx], bv, acc);
                }
                u32x2 o; o[0] = cvt_pk_bf16(acc[0], acc[1]); o[1] = cvt_pk_bf16(acc[2], acc[3]);
                *(u32x2*)(vblk + (16 * nt8 + ln) * 64 + 16 * wv4 + 4 * lq) = o;
            }
#pragma unroll
            for (int mm = 0; mm < 2; ++mm) {
                const int mt = 2 * wv4 + mm;
                bf16x8 ak[2];
#pragma unroll
                for (int ksx = 0; ksx < 2; ++ksx) ak[ksx] = *(const LAS bf16x8*)(rT + (16 * mt + ln) * 144 + (32 * ksx + 8 * lq) * 2);
#pragma unroll
                for (int nt4 = 0; nt4 < 4; ++nt4) {
                    f32x4 acc = (f32x4){0.f, 0.f, 0.f, 0.f};
#pragma unroll
                    for (int ksx = 0; ksx < 2; ++ksx) {
                        const bf16x8 bh = *(const LAS bf16x8*)(Thi + (16 * nt4 + ln) * 72 + 32 * ksx + 8 * lq);
                        acc = mfma16(ak[ksx], bh, acc);
                    }
                    u32x2 o; o[0] = cvt_pk_bf16(acc[0], acc[1]); o[1] = cvt_pk_bf16(acc[2], acc[3]);
                    *(u32x2*)(wblk + (16 * nt4 + ln) * 128 + 16 * mt + 4 * lq) = o;
                }
            }
        }
        P2_BAR();
    }
}

#undef P2_BAR
__device__ __forceinline__ void scan_phase(const Params& P, int l, LAS unsigned char* lds) {
    constexpr int W_OFF = 0, QD_OFF = 17408, KT_OFF = 34816, AT_OFF = 53248, OP_BYTES = 62464, ST_OFF = 2 * OP_BYTES, VT_OFF = ST_OFF + 8704;
    const int tid = opaque_tid(), lane = tid & 63, wv = tid >> 6, m = wv & 3, nt = wv >> 2;
    const bf16_t* qs = slotp(P, 2); const bf16_t* ks = slotp(P, 3); bf16_t* vs = slotp(P, 4); const bf16_t* wsl = slotp(P, 1); const bf16_t* ats = slotp(P, 6);
    const float* gtot = (const float*)(P.ws + WS_GTOT);
    const int ln = lane & 15, lq = lane >> 4;
    const int cid = (int)*(volatile LAS unsigned*)(lds + LDS_ST + 8);
    const bool remap = gridDim.x == 256u;
    const int it0 = (cid & 7) * 32 + (cid >> 3);
    for (int itx = blockIdx.x; itx < 768; itx += gridDim.x) {
        const int it = (remap && itx < 256) ? it0 : itx;
        int b, h, part, nsteps, ch0; bool smp;
        if (it < 256) { const int bh = it >> 2; part = it & 3; b = bh >> 3; h = bh & 7; nsteps = 64; ch0 = (b * 64) * 8 + h; smp = false; }
        else { const int j = it - 256, bh = j >> 2; part = j & 3; b = bh >> 3; h = bh & 7; nsteps = 1; ch0 = (512 + b) * 8 + h; smp = true; }
        f32x4 accS[2];
        float* sout = P.out + (smp ? O_DELTAS + ((size_t)(l * 16 + b) * 8 + h) * 16384 : O_DELTAP + ((size_t)(l * 8 + b) * 8 + h) * 16384);
#pragma unroll
        for (int t = 0; t < 2; ++t)
#pragma unroll
            for (int rg = 0; rg < 4; ++rg) {
                const int dk = 16 * wv + lq * 4 + rg, dv = part * 32 + 16 * t + ln;
                accS[t][rg] = smp ? P.state_delta[((size_t)(l * 16 + b) * 8 + h) * 16384 + dk * 128 + dv] : 0.f;
            }
        auto write_st = [&]() __attribute__((always_inline)) {
#pragma unroll
            for (int t = 0; t < 2; ++t) { u32x2 o; o[0] = cvt_pk_bf16(accS[t][0], accS[t][1]); o[1] = cvt_pk_bf16(accS[t][2], accS[t][3]);
                *(LAS u32x2*)(lds + ST_OFF + (16 * t + ln) * 272 + (16 * wv + lq * 4) * 2) = o; }
        };
        u32x4 pw[2], pq[2], pk[2], pa;
        auto gload = [&](int ch) __attribute__((always_inline)) {
            const u32x4* gw = (const u32x4*)(wsl + (size_t)ch * 8192); const u32x4* gq = (const u32x4*)(qs + (size_t)ch * 8192); const u32x4* gk = (const u32x4*)(ks + (size_t)ch * 8192);
            const u32x4* ga = (const u32x4*)(ats + (size_t)ch * 4096);
#pragma unroll
            for (int e = 0; e < 2; ++e) { pw[e] = gw[tid + 512 * e]; pq[e] = gq[tid + 512 * e]; pk[e] = gk[tid + 512 * e]; }
            pa = ga[tid];
        };
        auto lstore = [&](int bo) __attribute__((always_inline)) {
#pragma unroll
            for (int e = 0; e < 2; ++e) { const int p = tid + 512 * e;
                *(LAS u32x4*)(lds + bo + W_OFF + (p >> 4) * 272 + (p & 15) * 16) = pw[e];
                *(LAS u32x4*)(lds + bo + QD_OFF + (p >> 4) * 272 + (p & 15) * 16) = pq[e];
                *(LAS u32x4*)(lds + bo + KT_OFF + (p >> 3) * 144 + (p & 7) * 16) = pk[e]; }
            *(LAS u32x4*)(lds + bo + AT_OFF + (tid >> 3) * 144 + (tid & 7) * 16) = pa;
        };
#define LBAR() asm volatile("s_waitcnt lgkmcnt(0)\n\ts_barrier" ::: "memory")
        gload(ch0);
        write_st();
        lstore(0);
        bf16_t* up = vs + (size_t)ch0 * 8192 + (size_t)(part * 32 + 16 * nt + ln) * 64 + 16 * m + lq * 4;
        u32x2 uv = *(const u32x2*)up;
        float gt = gtot[ch0];
        if (nsteps > 1) gload(ch0 + 8);
        LBAR();
        for (int n = 0; n < nsteps; ++n) {
            const int ch = ch0 + n * 8;
            const int bo = (n & 1) * OP_BYTES;
            u32x2 uvn = uv; float gtn = gt;
            if (n + 1 < nsteps) {
                lstore(bo ^ OP_BYTES);
                uvn = *(const u32x2*)(up + 8 * 8192); gtn = gtot[ch + 8];
                if (n + 2 < nsteps) gload(ch + 16);
            }
            f32x4 accV = (f32x4){0.f, 0.f, 0.f, 0.f}, accQ = (f32x4){0.f, 0.f, 0.f, 0.f};
#pragma unroll
            for (int ksx = 0; ksx < 4; ++ksx) {
                const int ko = (32 * ksx + lq * 8) * 2;
                const bf16x8 aw = *(const LAS bf16x8*)(lds + bo + W_OFF + (16 * m + ln) * 272 + ko);
                const bf16x8 aq = *(const LAS bf16x8*)(lds + bo + QD_OFF + (16 * m + ln) * 272 + ko);
                const bf16x8 bs = *(const LAS bf16x8*)(lds + ST_OFF + (16 * nt + ln) * 272 + ko);
                accV = mfma16(aw, bs, accV); accQ = mfma16(aq, bs, accQ);
            }
            {
                const float u0 = __uint_as_float(uv[0] << 16), u1 = __uint_as_float(uv[0] & 0xffff0000u), u2 = __uint_as_float(uv[1] << 16), u3 = __uint_as_float(uv[1] & 0xffff0000u);
                u32x2 o; o[0] = cvt_pk_bf16(u0 - accV[0], u1 - accV[1]); o[1] = cvt_pk_bf16(u2 - accV[2], u3 - accV[3]);
                *(LAS u32x2*)(lds + VT_OFF + (16 * nt + ln) * 144 + (16 * m + lq * 4) * 2) = o;
            }
            LBAR();
#pragma unroll
            for (int ksx = 0; ksx < 2; ++ksx) {
                const int ko = (32 * ksx + lq * 8) * 2;
                const bf16x8 aa = *(const LAS bf16x8*)(lds + bo + AT_OFF + (16 * m + ln) * 144 + ko);
                const bf16x8 bv = *(const LAS bf16x8*)(lds + VT_OFF + (16 * nt + ln) * 144 + ko);
                accQ = mfma16(aa, bv, accQ);
            }
            { u32x2 o; o[0] = cvt_pk_bf16(accQ[0], accQ[1]); o[1] = cvt_pk_bf16(accQ[2], accQ[3]); *(u32x2*)up = o; }
#pragma unroll
            for (int t = 0; t < 2; ++t) {
                accS[t] = accS[t] * gt;
#pragma unroll
                for (int ksx = 0; ksx < 2; ++ksx) {
                    const int ko = (32 * ksx + lq * 8) * 2;
                    const bf16x8 ak = *(const LAS bf16x8*)(lds + bo + KT_OFF + (16 * wv + ln) * 144 + ko);
                    const bf16x8 bv = *(const LAS bf16x8*)(lds + VT_OFF + (16 * t + ln) * 144 + ko);
                    accS[t] = mfma16(ak, bv, accS[t]);
                }
            }
            write_st();
            LBAR();
            uv = uvn; gt = gtn; up += 8 * 8192;
        }
#undef LBAR
        __syncthreads();
#pragma unroll
        for (int t = 0; t < 2; ++t)
#pragma unroll
            for (int rg = 0; rg < 4; ++rg) { const int dk = 16 * wv + lq * 4 + rg, dv = part * 32 + 16 * t + ln; sout[dk * 128 + dv] = accS[t][rg]; }
    }
}

__device__ __forceinline__ void merge_phase(const Params& P, int l, LAS unsigned char* lds) {
    const int tid = opaque_tid();
    const bf16_t* os = slotp(P, 4); const bf16_t* zs = slotp(P, 5); bf16_t* mg = slotp(P, 2);
    const bf16_t* ma = (const bf16_t*)P.out; const bf16_t* gb = ma + (size_t)R * 1024;
    const float* gain = P.o_gain + l * 128;
    const int j = tid >> 3, g8 = tid & 7;
    u32x4 pre[2];
    u32x4 zr[2], gr[2], mr[2], nzr[2], ngr[2], nmr[2]; f32x4 gn[4];
#pragma unroll
    for (int e = 0; e < 2; ++e) { gn[2 * e] = *(const f32x4*)(gain + g8 * 16 + e * 8); gn[2 * e + 1] = *(const f32x4*)(gain + g8 * 16 + e * 8 + 4); }
    auto item_off = [&](int c2) __attribute__((always_inline)) -> size_t {
        const bool sm = c2 >= 4096; const int ck = c2 >> 3, hh = c2 & 7;
        const int rr0 = sm ? RP + (ck - 512) * 32 : ck * 64, nv = sm ? 32 : 64;
        return (size_t)(rr0 + (j < nv ? j : 0)) * 1024 + hh * 128 + g8 * 16;
    };
    if ((int)blockIdx.x < NCHH) { const u32x4* src = (const u32x4*)(os + (size_t)blockIdx.x * 8192); pre[0] = src[tid]; pre[1] = src[tid + 512];
        const size_t o0 = item_off(blockIdx.x);
#pragma unroll
        for (int e = 0; e < 2; ++e) { zr[e] = *(const u32x4*)(zs + o0 + e * 8); gr[e] = *(const u32x4*)(gb + o0 + e * 8); mr[e] = *(const u32x4*)(ma + o0 + e * 8); } }
    for (int ch = blockIdx.x; ch < NCHH; ch += gridDim.x) {
        const bool smp = ch >= 4096; const int chunk = ch >> 3, h = ch & 7;
        const int r0 = smp ? RP + (chunk - 512) * 32 : chunk * 64, nvalid = smp ? 32 : 64;
#pragma unroll
        for (int e = 0; e < 2; ++e) { const int p = tid + 512 * e; const int dvr = p >> 3; *(LAS u32x4*)(lds + ((dvr & 15) * 8 + (dvr >> 4)) * 144 + (p & 7) * 16) = pre[e]; }
        if (ch + (int)gridDim.x < NCHH) {
            const int c2 = ch + gridDim.x;
            const u32x4* src = (const u32x4*)(os + (size_t)c2 * 8192); pre[0] = src[tid]; pre[1] = src[tid + 512];
            const size_t o2 = item_off(c2);
#pragma unroll
            for (int e = 0; e < 2; ++e) { nzr[e] = *(const u32x4*)(zs + o2 + e * 8); ngr[e] = *(const u32x4*)(gb + o2 + e * 8); nmr[e] = *(const u32x4*)(ma + o2 + e * 8); }
        }
        const size_t off = (size_t)(r0 + (j < nvalid ? j : 0)) * 1024 + h * 128 + g8 * 16;
        __syncthreads();
        float o[16]; float ss = 0.f;
#pragma unroll
        for (int d = 0; d < 16; ++d) { o[d] = bf2f(*(const LAS bf16_t*)(lds + (d * 8 + g8) * 144 + j * 2)); ss += o[d] * o[d]; }
        ss += __shfl_xor(ss, 1); ss += __shfl_xor(ss, 2); ss += __shfl_xor(ss, 4);
        const float rn = rsqrtf(ss * (1.f / 128.f) + 1e-6f);
        if (j < nvalid) {
#pragma unroll
            for (int e = 0; e < 2; ++e) {
                float zv[8], gv[8], mv[8];
                unpack8(zr[e], zv); unpack8(gr[e], gv); unpack8(mr[e], mv);
                const f32x4 g0 = gn[2 * e], g1 = gn[2 * e + 1];
                f32x4 r0v, r1v;
#pragma unroll
                for (int q = 0; q < 4; ++q) {
                    r0v[q] = mv[q] + sigm(gv[q]) * (o[e * 8 + q] * rn * g0[q] * silu(zv[q]));
                    r1v[q] = mv[4 + q] + sigm(gv[4 + q]) * (o[e * 8 + 4 + q] * rn * g1[q] * silu(zv[4 + q]));
                }
                *(u32x4*)(mg + off + e * 8) = pack8(r0v, r1v);
            }
        }
#pragma unroll
        for (int e = 0; e < 2; ++e) { zr[e] = nzr[e]; gr[e] = ngr[e]; mr[e] = nmr[e]; }
        __syncthreads();
    }
}

#ifndef DBG_SLOTMASK
#define DBG_SLOTMASK 0
#endif
#ifndef DBG_RANGE
#define DBG_RANGE (RP * 1024)
#endif
template <int S> __device__ __forceinline__ void run_stage(const Params& P, int l, LAS unsigned char* lds) {
    bf16_t* wb = wbf(P);
    if constexpr (S == 11) {
        ln_phase(P, P.x_prompt, P.x_sample, P.ln_in_g, P.ln_in_b, slotp(P, 0), nullptr, 0, lds);
        __syncthreads();
        convert_weights(P, 0, lds);
    } else if constexpr (S == 12) {
        const size_t n = O_DELTAS + 2ull * 16 * 8 * 16384;
        const float* ab = (const float*)(P.ws + WS_AB);
        constexpr int SM = DBG_SLOTMASK;
        for (size_t i = (size_t)blockIdx.x * 512 + opaque_tid(); i < n; i += (size_t)gridDim.x * 512) {
            float v = 0.f;
            if ((SM & 256) && i < (size_t)R * 1024) { v = P.out[i]; if (!(fabsf(v) < 1e30f)) v = 777.f; }
            if ((SM & 1024) && i >= (size_t)R * 1024) { v = P.out[i]; if (!(fabsf(v) < 1e30f)) v = 777.f; }
            const size_t si = i % ((size_t)DBG_RANGE);
#pragma unroll
            for (int q = 0; q < 7; ++q) if ((SM >> q) & 1) { float w = bf2f(slotp(P, q)[si]); if (!(fabsf(w) < 1e30f)) w = 777.f; v += w * (float)(q + 1); }
            if (SM & 128) { float w = bf2f(wbf(P)[i % WB_E]); if (!(fabsf(w) < 1e30f)) w = 777.f; v += w; }
            if ((SM & 512) && i < (size_t)R * 16) { float w = ab[i]; if (!(fabsf(w) < 1e30f)) w = 777.f; v += w; }
            P.out[i] = v;
        }
    } else if constexpr (S == 13) {
        const size_t n = O_DELTAS + 2ull * 16 * 8 * 16384;
        for (size_t i = (size_t)blockIdx.x * 512 + opaque_tid(); i < n; i += (size_t)gridDim.x * 512) { const float v = P.out[i]; if (!(fabsf(v) < 1e30f)) P.out[i] = 777.f; }
    } else if constexpr (S == 0) { EpiIn E; E.up = slotp(P, 1); E.q = slotp(P, 2); E.z = slotp(P, 5); E.ga = (bf16_t*)P.out; E.halo = (bf16_t*)(P.ws + WS_HALO);
        E.pool_p = P.out + O_POOLP + (size_t)l * 8 * 15 * 1024; E.conv_p = P.out + O_CONVP + (size_t)l * 8 * 3 * 3072;
        E.pool_s = P.out + O_POOLS + (size_t)l * 16 * 15 * 1024; E.conv_s = P.out + O_CONVS + (size_t)l * 16 * 3 * 3072;
        run_gemm(lds, slotp(P, 0), 1024, 0, wb + WIN_E, R, 7168, 1024, E);
    } else if constexpr (S == 1) { mixed_phase(P, l);
    } else if constexpr (S == 2) { EpiPool E; E.ga = (bf16_t*)P.out; E.scale = P.pool_scale + l * 1024; run_gemm(lds, slotp(P, 6), 1024, 256, wb + WPOOL_E, R, 1024, 256, E);
    } else if constexpr (S == 3) { delta_pre_phase(P, l, lds);
    } else if constexpr (S == 4) { scan_phase(P, l, lds);
    } else if constexpr (S == 5) { merge_phase(P, l, lds);
    } else if constexpr (S == 6) { EpiRes E; E.res = slotp(P, 0); E.bias = nullptr; E.out = slotp(P, 5); E.part = (float*)(P.ws + WS_PART);
        run_gemm(lds, slotp(P, 2), 1024, 0, wb + WOUT_E, RP, 1024, 1024, E);
        E.res += (size_t)RP * 1024; E.out += (size_t)RP * 1024;
        run_gemm(lds, slotp(P, 2) + (size_t)RP * 1024, 1024, 0, wb + WOUT_E, RS, 1024, 1024, E, 4);
    } else if constexpr (S == 7) { ln_phase(P, nullptr, nullptr, P.ln1_g + l * 1024, P.ln1_b + l * 1024, slotp(P, 0), nullptr, -1, lds, (const float*)(P.ws + WS_PART), slotp(P, 5));
    } else if constexpr (S == 8) { EpiFF1 E; E.h = slotp(P, 1); E.bias = P.b_ff1 + l * 4096; run_gemm(lds, slotp(P, 0), 1024, 0, wb + WFF1_E, R, 4096, 1024, E);
    } else if constexpr (S == 9) { EpiRes E; E.res = slotp(P, 0); E.bias = P.b_ff2 + l * 1024; E.out = slotp(P, 5); E.part = (float*)(P.ws + WS_PART);
        run_gemm(lds, slotp(P, 1), 4096, 0, wb + WFF2_E, RP, 1024, 4096, E);
        E.res += (size_t)RP * 1024; E.out += (size_t)RP * 1024;
        run_gemm(lds, slotp(P, 1) + (size_t)RP * 4096, 4096, 0, wb + WFF2_E, RS, 1024, 4096, E, 4);
    } else {
        if (l == 0) { ln_phase(P, nullptr, nullptr, P.ln2_g, P.ln2_b, slotp(P, 0), nullptr, 1, lds, (const float*)(P.ws + WS_PART), slotp(P, 5)); __syncthreads(); convert_weights(P, 1, lds); }
        else ln_phase(P, nullptr, nullptr, P.ln2_g + 1024, P.ln2_b + 1024, nullptr, P.out, -1, lds, (const float*)(P.ws + WS_PART), slotp(P, 5));
    }
}
constexpr int NPHASES = 23;
__device__ __forceinline__ void run_phase(const Params& P, int ph, LAS unsigned char* lds) {
    if (ph == 0) { run_stage<11>(P, 0, lds); return; }
    const int l = (ph - 1) / 11, s = (ph - 1) % 11;
    switch (s) {
    case 0: run_stage<0>(P, l, lds); break;
    case 1: run_stage<1>(P, l, lds); break;
    case 2: run_stage<2>(P, l, lds); break;
    case 3: run_stage<3>(P, l, lds); break;
    case 4: run_stage<4>(P, l, lds); break;
    case 5: run_stage<5>(P, l, lds); break;
    case 6: run_stage<6>(P, l, lds); break;
    case 7: run_stage<7>(P, l, lds); break;
    case 8: run_stage<8>(P, l, lds); break;
    case 9: run_stage<9>(P, l, lds); break;
    default: run_stage<10>(P, l, lds); break;
    }
}

#if MK_SINGLE
__global__ void __launch_bounds__(512, 2) mega(Params P, int ph_lo, int ph_hi) {
    extern __shared__ __attribute__((aligned(16))) unsigned char shm[];
    LAS unsigned char* lds = (LAS unsigned char*)shm;
    cg::grid_group grid = cg::this_grid();
    volatile LAS unsigned* st = (volatile LAS unsigned*)(lds + LDS_ST);
    if (threadIdx.x == 0) { st[0] = 0u; st[1] = 0u; }
    __syncthreads();
    XcdBarrier xb; xb.bar = (unsigned*)(P.ws + WS_BAR); xb.x = xb_xcc_id(); xb.st = st;
    if (threadIdx.x == 0) {
        st[3] = xb_add(&xb.bar[XB_XCNT(xb.x)], 1u);
        st[2] = blockIdx.x;
    }
    __syncthreads();
    for (int ph = ph_lo; ph < ph_hi; ++ph) {
        if (ph_hi < 0) grid.sync();
        if (ph > ph_lo) xcd_barrier(xb);
        if (ph == ph_lo + 1) {
            if (threadIdx.x == 0) {
                bool ok = gridDim.x == 256u && xb.x < 8u;
                for (unsigned j = 0; j < 16; ++j) ok = ok && (xb_ld(&xb.bar[XB_XCNT(j)]) == (j < 8u ? 32u : 0u));
                if (ok) st[2] = xb.x + 8u * st[3];
            }
            __syncthreads();
        }
        run_phase(P, ph, lds);
    }
}
#else
template <int S> __global__ void __launch_bounds__(512, 2) stage_kernel(Params P, int l) {
    extern __shared__ __attribute__((aligned(16))) unsigned char shm[];
    if (threadIdx.x == 0) *(volatile LAS unsigned*)((LAS unsigned char*)shm + LDS_ST + 8) = blockIdx.x;
    __syncthreads();
    run_stage<S>(P, l, (LAS unsigned char*)shm);
}
template <int S> static void launch_stage(const Params& p, int l, int grid, hipStream_t stream) {
    static bool attr = false;
    if (!attr) { (void)hipFuncSetAttribute((const void*)stage_kernel<S>, hipFuncAttributeMaxDynamicSharedMemorySize, LDS_BYTES); attr = true; }
    hipLaunchKernelGGL(stage_kernel<S>, dim3(grid), dim3(512), LDS_BYTES, stream, p, l);
}
static void launch_phase(const Params& p, int ph, int grid, hipStream_t stream) {
    if (ph == 0) { launch_stage<11>(p, 0, grid, stream); return; }
    const int l = (ph - 1) / 11, s = (ph - 1) % 11;
    switch (s) {
    case 0: launch_stage<0>(p, l, grid, stream); break;
    case 1: launch_stage<1>(p, l, grid, stream); break;
    case 2: launch_stage<2>(p, l, grid, stream); break;
    case 3: launch_stage<3>(p, l, grid, stream); break;
    case 4: launch_stage<4>(p, l, grid, stream); break;
    case 5: launch_stage<5>(p, l, grid, stream); break;
    case 6: launch_stage<6>(p, l, grid, stream); break;
    case 7: launch_stage<7>(p, l, grid, stream); break;
    case 8: launch_stage<8>(p, l, grid, stream); break;
    case 9: launch_stage<9>(p, l, grid, stream); break;
    default: launch_stage<10>(p, l, grid, stream); break;
    }
}
#endif

extern "C" void kernel_launch(void* const* d_in, const int* in_sizes, int n_in, void* d_out, int out_size, void* d_ws, size_t ws_size, hipStream_t stream) {
    static int grid = 0;
    if (grid == 0) {
        if (n_in != 23 || ws_size < WS_END) { fprintf(stderr, "kernel_launch: unexpected n_in %d or ws_size %zu (< %zu)\n", n_in, ws_size, (size_t)WS_END); grid = -1; return; }
        int dev = 0, cus = 0;
        (void)hipGetDevice(&dev);
        (void)hipDeviceGetAttribute(&cus, hipDeviceAttributeMultiprocessorCount, dev);
#if MK_SINGLE
        int per_cu = 0;
        if (hipFuncSetAttribute((const void*)mega, hipFuncAttributeMaxDynamicSharedMemorySize, LDS_BYTES) != hipSuccess) { fprintf(stderr, "kernel_launch: hipFuncSetAttribute failed\n"); grid = -1; return; }
        if (hipOccupancyMaxActiveBlocksPerMultiprocessor(&per_cu, (const void*)mega, 512, LDS_BYTES) != hipSuccess || per_cu < 1) per_cu = 1;
        (void)hipGetLastError();
        grid = cus * per_cu;
#else
        grid = cus;
#endif
        if (grid > 256) grid = 256;
    }
    if (grid < 0) return;
    Params p{};
    const float** pp = (const float**)&p;
    for (int i = 0; i < 23; ++i) pp[i] = (const float*)d_in[i];
    p.out = (float*)d_out; p.ws = (unsigned char*)d_ws;
#if MK_SINGLE
    int lo = 0, hi = NPHASES;
    (void)hipMemsetAsync((unsigned char*)d_ws + WS_BAR, 0, 3456 * 4, stream);
    void* args[] = {&p, &lo, &hi};
    hipError_t e = hipLaunchCooperativeKernel((const void*)mega, dim3(grid), dim3(512), args, LDS_BYTES, stream);
    if (e != hipSuccess) fprintf(stderr, "cooperative launch failed: %s (grid %d)\n", hipGetErrorString(e), grid);
#else
#ifdef DBG_NPH
    for (int ph = 0; ph < DBG_NPH; ++ph) launch_phase(p, ph, grid, stream);
    launch_stage<12>(p, 0, grid, stream);
#else
    for (int ph = 0; ph < NPHASES; ++ph) {
#ifdef DUP_GROUP_END
        if (ph > 0 && (ph - 1) % 11 == 0) for (int q = 0; q <= DUP_GROUP_END; ++q) launch_phase(p, ph + q, grid, stream);
#endif
        launch_phase(p, ph, grid, stream);
#ifdef DUP_MASK
        if (ph > 0 && ((DUP_MASK >> ((ph - 1) % 11)) & 1)) launch_phase(p, ph, grid, stream);
#endif
    }
#endif
#endif
}
```
